# Optimizing an MI355X kernel written in HIP

```python
import math, functools
import jax, jax.numpy as jnp
from jax import lax
import numpy as np

D_MODEL = 1024
BATCH = 8
SEQ = 2048
DEPTH = 4
DEC_BATCH = 128
DEC_SEQ = 8
PAST_LEN = 16384
PAGE_SIZE = 128

N_MIXERS = 3
N_GLA = (DEPTH + 2) // 3
N_GDN = (DEPTH + 1) // 3
N_S5 = DEPTH // 3
ALPHA_RES = (2 * DEPTH) ** 0.25
BETA_INIT = (8 * DEPTH) ** -0.25
LN_EPS = 1e-5
NORM_EPS = 1e-6
CHUNK = 64

GLA_HEADS = 4
GLA_KW = D_MODEL // 2
GLA_VW = D_MODEL
GLA_DK = GLA_KW // GLA_HEADS
GLA_DV = GLA_VW // GLA_HEADS
GLA_LOWRANK = 16
GLA_TAU = 16.0
GLA_IN = 2 * GLA_KW + 2 * GLA_VW + GLA_LOWRANK

GDN_HEADS = 8
GDN_DK = 128
GDN_DV = 128
GDN_KW = GDN_HEADS * GDN_DK
GDN_VW = GDN_HEADS * GDN_DV
GDN_CONV = 4
GDN_CONV_CH = 2 * GDN_KW + GDN_VW
GDN_IN = GDN_CONV_CH + GDN_VW + 2 * GDN_HEADS

S5_WIDTH = D_MODEL
S5_GROUP = 16
S5_GROUPS = S5_WIDTH // S5_GROUP
S5_STATE = 64
S5_IN = 2 * S5_WIDTH

F32 = jnp.float32

kernel_name = 'hybrid_gla_gdn_s5_deepnorm_step'


def layer_norm(x, g, b):
    xf = x.astype(F32)
    mu = jnp.mean(xf, -1, keepdims=True)
    var = jnp.mean(jnp.square(xf - mu), -1, keepdims=True)
    return ((xf - mu) * lax.rsqrt(var + LN_EPS) * g.astype(F32) + b.astype(F32)).astype(x.dtype)


def rms_head(o, g):
    return o * lax.rsqrt(jnp.mean(jnp.square(o), -1, keepdims=True) + NORM_EPS) * g.astype(F32)


def l2_normalize(t):
    return t * lax.rsqrt(jnp.sum(jnp.square(t), -1, keepdims=True) + NORM_EPS)


def to_chunks(t, c):
    bt, L = t.shape[:2]
    t = t.reshape((bt, L // c, c) + t.shape[2:])
    return t.transpose((1, 0, 3, 2) + tuple(range(4, t.ndim)))


def from_chunks(t):
    n, bt, h, c, d = t.shape
    return t.transpose(1, 0, 3, 2, 4).reshape(bt, n * c, h, d)


def gla_chunked(q, k, v, log_a, s0):
    L = q.shape[1]
    c = math.gcd(L, CHUNK)
    q, k, v, log_a = (to_chunks(t, c) for t in (q, k, v, log_a))
    b = jnp.cumsum(log_a, axis=-2)
    q_dec = q * jnp.exp(b)
    k_inv = k * jnp.exp(-b)
    k_end = k * jnp.exp(b[..., -1:, :] - b)
    incl = jnp.tril(jnp.ones((c, c), bool))
    att = jnp.where(incl, jnp.einsum('nbhid,nbhjd->nbhij', q_dec, k_inv), 0.0)
    o_intra = jnp.einsum('nbhij,nbhjv->nbhiv', att, v)

    def step(s, inp):
        qd, ke, vv, bl = inp
        o_inter = jnp.einsum('bhid,bhdv->bhiv', qd, s)
        s = s * jnp.exp(bl)[..., None] + jnp.einsum('bhjd,bhjv->bhdv', ke, vv)
        return s, o_inter

    s, o_inter = lax.scan(step, s0, (q_dec, k_end, v, b[..., -1, :]))
    return from_chunks(o_intra + o_inter), s


def gdn_chunked(q, k, v, g, beta, s0):
    L = q.shape[1]
    c = math.gcd(L, CHUNK)
    q, k, v = (to_chunks(t, c) for t in (q, k, v))
    g, beta = to_chunks(g, c), to_chunks(beta, c)
    gc = jnp.cumsum(g, axis=-1)
    incl = jnp.tril(jnp.ones((c, c), bool))
    strict = jnp.tril(jnp.ones((c, c), bool), -1)
    decay = jnp.exp(jnp.where(incl, gc[..., :, None] - gc[..., None, :], -jnp.inf))
    kb = k * beta[..., None]
    a_mat = jnp.where(strict, jnp.einsum('nbhid,nbhjd->nbhij', kb, k) * decay, 0.0)
    lhs = a_mat + jnp.eye(c, dtype=a_mat.dtype)
    solve = functools.partial(lax.linalg.triangular_solve, left_side=True, lower=True, unit_diagonal=True)
    u = solve(lhs, v * beta[..., None])
    w = solve(lhs, kb * jnp.exp(gc)[..., None])
    att = jnp.einsum('nbhid,nbhjd->nbhij', q, k) * decay
    q_dec = q * jnp.exp(gc)[..., None]
    k_end = k * jnp.exp(gc[..., -1:] - gc)[..., None]
    g_end = jnp.exp(gc[..., -1])

    def step(s, inp):
        qd, ke, uu, ww, aa, ge = inp
        v_new = uu - jnp.einsum('bhcd,bhdv->bhcv', ww, s)
        o = jnp.einsum('bhcd,bhdv->bhcv', qd, s) + jnp.einsum('bhij,bhjv->bhiv', aa, v_new)
        s = s * ge[..., None, None] + jnp.einsum('bhcd,bhcv->bhdv', ke, v_new)
        return s, o

    s, o = lax.scan(step, s0, (q_dec, k_end, u, w, att, g_end))
    return from_chunks(o), s


def complex_affine_combine(e1, e2):
    a1r, a1i, b1r, b1i = e1
    a2r, a2i, b2r, b2i = e2
    return (a2r * a1r - a2i * a1i, a2r * a1i + a2i * a1r,
            a2r * b1r - a2i * b1i + b2r, a2r * b1i + a2i * b1r + b2i)


def gla_mixer(x, w_in, w_a2, b_a, norm_g, w_out, s0):
    bt, L, _ = x.shape
    h = jnp.einsum('bld,de->ble', x, w_in).astype(F32)
    q, k, v, r, lr = jnp.split(h, [GLA_KW, 2 * GLA_KW, 2 * GLA_KW + GLA_VW, 2 * GLA_KW + 2 * GLA_VW], axis=-1)
    log_a = jax.nn.log_sigmoid(jnp.einsum('blr,rk->blk', lr, w_a2.astype(F32)) + b_a.astype(F32)) / GLA_TAU
    heads = lambda t, d: t.reshape(bt, L, GLA_HEADS, d)
    o, s = gla_chunked(heads(q, GLA_DK) * GLA_DK ** -0.5, heads(k, GLA_DK), heads(v, GLA_DV),
                       heads(log_a, GLA_DK), s0.astype(F32))
    o = rms_head(o, norm_g) * jax.nn.silu(heads(r, GLA_DV))
    out = jnp.einsum('ble,ed->bld', o.reshape(bt, L, GLA_VW), w_out.astype(F32))
    return out.astype(x.dtype), s


def gdn_mixer(x, w_in, w_conv, a_log, dt_bias, norm_g, w_out, conv0, s0):
    bt, L, _ = x.shape
    h = jnp.einsum('bld,de->ble', x, w_in).astype(F32)
    qkv, z, a, b = jnp.split(h, [GDN_CONV_CH, GDN_CONV_CH + GDN_VW, GDN_CONV_CH + GDN_VW + GDN_HEADS], axis=-1)
    ext = jnp.concatenate([conv0.astype(F32), qkv], axis=1)
    wc = w_conv.astype(F32)
    conv = ext[:, 0:L] * wc[0]
    for t in range(1, GDN_CONV):
        conv = conv + ext[:, t:t + L] * wc[t]
    conv_new = ext[:, L:]
    qkv = jax.nn.silu(conv)
    q, k, v = jnp.split(qkv, [GDN_KW, 2 * GDN_KW], axis=-1)
    q = l2_normalize(q.reshape(bt, L, GDN_HEADS, GDN_DK)) * GDN_DK ** -0.5
    k = l2_normalize(k.reshape(bt, L, GDN_HEADS, GDN_DK))
    v = v.reshape(bt, L, GDN_HEADS, GDN_DV)
    g = -jnp.exp(a_log.astype(F32)) * jax.nn.softplus(a + dt_bias.astype(F32))
    beta = jax.nn.sigmoid(b)
    o, s = gdn_chunked(q, k, v, g, beta, s0.astype(F32))
    o = rms_head(o, norm_g) * jax.nn.silu(z.reshape(bt, L, GDN_HEADS, GDN_DV))
    out = jnp.einsum('ble,ed->bld', o.reshape(bt, L, GDN_VW), w_out.astype(F32))
    return out.astype(x.dtype), conv_new, s


def s5_mixer(x, w_in, lam_re, lam_im, log_dt, b_re, b_im, c_re, c_im, d, w_glu, b_glu, w_out, h0_re, h0_im):
    bt, L, _ = x.shape
    h = jnp.einsum('bld,de->ble', x, w_in).astype(F32)
    u, z = jnp.split(h, [S5_WIDTH], axis=-1)
    ug = u.reshape(bt, L, S5_GROUPS, S5_GROUP)
    lam_re, lam_im = lam_re.astype(F32), lam_im.astype(F32)
    dt = jnp.exp(log_dt.astype(F32))[:, None]
    mag = jnp.exp(lam_re * dt)
    ab_re, ab_im = mag * jnp.cos(lam_im * dt), mag * jnp.sin(lam_im * dt)
    den = jnp.square(lam_re) + jnp.square(lam_im)
    num_re = ab_re - 1.0
    coef_re = (num_re * lam_re + ab_im * lam_im) / den
    coef_im = (ab_im * lam_re - num_re * lam_im) / den
    br, bi = b_re.astype(F32), b_im.astype(F32)
    bb_re = coef_re[..., None] * br - coef_im[..., None] * bi
    bb_im = coef_re[..., None] * bi + coef_im[..., None] * br
    bu_re = jnp.einsum('gpc,blgc->blgp', bb_re, ug)
    bu_im = jnp.einsum('gpc,blgc->blgp', bb_im, ug)
    h0r, h0i = h0_re.astype(F32), h0_im.astype(F32)
    bu_re = bu_re.at[:, 0].add(ab_re * h0r - ab_im * h0i)
    bu_im = bu_im.at[:, 0].add(ab_re * h0i + ab_im * h0r)
    a_re = jnp.broadcast_to(ab_re, bu_re.shape)
    a_im = jnp.broadcast_to(ab_im, bu_im.shape)
    _, _, hs_re, hs_im = lax.associative_scan(complex_affine_combine, (a_re, a_im, bu_re, bu_im), axis=1)
    y = (jnp.einsum('gcp,blgp->blgc', c_re.astype(F32), hs_re)
         - jnp.einsum('gcp,blgp->blgc', c_im.astype(F32), hs_im) + d.astype(F32) * ug)
    y = jax.nn.gelu(y.reshape(bt, L, S5_WIDTH))
    y1, y2 = jnp.split(jnp.einsum('blw,wv->blv', y, w_glu.astype(F32)) + b_glu.astype(F32), 2, axis=-1)
    y = y1 * jax.nn.sigmoid(y2) * jax.nn.silu(z)
    out = jnp.einsum('blw,wd->bld', y, w_out.astype(F32))
    return out.astype(x.dtype), hs_re[:, -1], hs_im[:, -1]


def trunk(x, st_gla, st_gdn, st_conv, st_re, st_im, wts):
    out_gla, out_gdn, out_conv, out_re, out_im = [], [], [], [], []
    for i in range(DEPTH):
        j = i // N_MIXERS
        kind = i % N_MIXERS
        if kind == 0:
            f, s = gla_mixer(x, wts['gla_w_in'][j], wts['gla_w_a2'][j], wts['gla_b_a'][j],
                             wts['gla_norm_g'][j], wts['gla_w_out'][j], st_gla[j])
            out_gla.append(s)
        elif kind == 1:
            f, cv, s = gdn_mixer(x, wts['gdn_w_in'][j], wts['gdn_w_conv'][j], wts['gdn_a_log'][j],
                                 wts['gdn_dt_bias'][j], wts['gdn_norm_g'][j], wts['gdn_w_out'][j],
                                 st_conv[j], st_gdn[j])
            out_gdn.append(s)
            out_conv.append(cv)
        else:
            f, hr, hi = s5_mixer(x, wts['s5_w_in'][j], wts['s5_lam_re'][j], wts['s5_lam_im'][j],
                                 wts['s5_log_dt'][j], wts['s5_b_re'][j], wts['s5_b_im'][j],
                                 wts['s5_c_re'][j], wts['s5_c_im'][j], wts['s5_d'][j],
                                 wts['s5_w_glu'][j], wts['s5_b_glu'][j], wts['s5_w_out'][j],
                                 st_re[j], st_im[j])
            out_re.append(hr)
            out_im.append(hi)
        x = layer_norm(ALPHA_RES * x + f, wts['ln_g'][i], wts['ln_b'][i])
    return (x, jnp.stack(out_gla), jnp.stack(out_gdn), jnp.stack(out_conv),
            jnp.stack(out_re), jnp.stack(out_im))


def setup_inputs(seed: int = 0) -> dict:
    key = jax.random.key(seed)
    ks = iter(jax.random.split(key, 48))
    nrm = lambda shape, scale: jax.random.normal(next(ks), shape, F32) * scale
    uni = lambda shape, lo, hi: jax.random.uniform(next(ks), shape, F32, lo, hi)
    x_prompt = nrm((BATCH, SEQ, D_MODEL), 1.0)
    x_sample = nrm((DEC_BATCH, DEC_SEQ, D_MODEL), 1.0)
    state_gla = nrm((N_GLA, DEC_BATCH, GLA_HEADS, GLA_DK, GLA_DV), 0.1)
    state_gdn = nrm((N_GDN, DEC_BATCH, GDN_HEADS, GDN_DK, GDN_DV), 0.1)
    state_gdn_conv = nrm((N_GDN, DEC_BATCH, GDN_CONV - 1, GDN_CONV_CH), 1.0)
    state_s5_re = nrm((N_S5, DEC_BATCH, S5_GROUPS, S5_STATE), 0.5)
    state_s5_im = nrm((N_S5, DEC_BATCH, S5_GROUPS, S5_STATE), 0.5)
    ln_g = 1.0 + nrm((DEPTH, D_MODEL), 0.01)
    ln_b = nrm((DEPTH, D_MODEL), 0.01)
    gla_w_in = nrm((N_GLA, D_MODEL, GLA_IN), D_MODEL ** -0.5)
    gla_w_a2 = nrm((N_GLA, GLA_LOWRANK, GLA_KW), GLA_LOWRANK ** -0.5)
    gla_b_a = nrm((N_GLA, GLA_KW), 0.1)
    gla_norm_g = 1.0 + nrm((N_GLA, GLA_DV), 0.01)
    gla_w_out = nrm((N_GLA, GLA_VW, D_MODEL), GLA_VW ** -0.5 * BETA_INIT)
    gdn_w_in = nrm((N_GDN, D_MODEL, GDN_IN), D_MODEL ** -0.5)
    gdn_w_conv = nrm((N_GDN, GDN_CONV, GDN_CONV_CH), GDN_CONV ** -0.5)
    gdn_a_log = jnp.log(uni((N_GDN, GDN_HEADS), 1.0, 16.0))
    gdn_dt = jnp.exp(uni((N_GDN, GDN_HEADS), math.log(1e-3), math.log(1e-1)))
    gdn_dt_bias = gdn_dt + jnp.log(-jnp.expm1(-gdn_dt))
    gdn_norm_g = 1.0 + nrm((N_GDN, GDN_DV), 0.01)
    gdn_w_out = nrm((N_GDN, GDN_VW, D_MODEL), GDN_VW ** -0.5 * BETA_INIT)
    s5_w_in = nrm((N_S5, D_MODEL, S5_IN), D_MODEL ** -0.5)
    s5_lam_re = -0.5 + nrm((N_S5, S5_GROUPS, S5_STATE), 0.01)
    s5_lam_im = math.pi * jnp.arange(S5_STATE, dtype=F32) + nrm((N_S5, S5_GROUPS, S5_STATE), 0.01)
    s5_log_dt = uni((N_S5, S5_GROUPS), math.log(1e-3), math.log(1e-1))
    s5_b_re = nrm((N_S5, S5_GROUPS, S5_STATE, S5_GROUP), (2 * S5_GROUP) ** -0.5)
    s5_b_im = nrm((N_S5, S5_GROUPS, S5_STATE, S5_GROUP), (2 * S5_GROUP) ** -0.5)
    s5_c_re = nrm((N_S5, S5_GROUPS, S5_GROUP, S5_STATE), (2 * S5_STATE) ** -0.5)
    s5_c_im = nrm((N_S5, S5_GROUPS, S5_GROUP, S5_STATE), (2 * S5_STATE) ** -0.5)
    s5_d = nrm((N_S5, S5_GROUPS, S5_GROUP), 1.0)
    s5_w_glu = nrm((N_S5, S5_WIDTH, 2 * S5_WIDTH), S5_WIDTH ** -0.5)
    s5_b_glu = nrm((N_S5, 2 * S5_WIDTH), 0.01)
    s5_w_out = nrm((N_S5, S5_WIDTH, D_MODEL), S5_WIDTH ** -0.5 * BETA_INIT)
    return {'x_prompt': x_prompt, 'x_sample': x_sample,
            'state_gla': state_gla, 'state_gdn': state_gdn, 'state_gdn_conv': state_gdn_conv,
            'state_s5_re': state_s5_re, 'state_s5_im': state_s5_im,
            'ln_g': ln_g, 'ln_b': ln_b,
            'gla_w_in': gla_w_in, 'gla_w_a2': gla_w_a2, 'gla_b_a': gla_b_a,
            'gla_norm_g': gla_norm_g, 'gla_w_out': gla_w_out,
            'gdn_w_in': gdn_w_in, 'gdn_w_conv': gdn_w_conv, 'gdn_a_log': gdn_a_log,
            'gdn_dt_bias': gdn_dt_bias, 'gdn_norm_g': gdn_norm_g, 'gdn_w_out': gdn_w_out,
            's5_w_in': s5_w_in, 's5_lam_re': s5_lam_re, 's5_lam_im': s5_lam_im, 's5_log_dt': s5_log_dt,
            's5_b_re': s5_b_re, 's5_b_im': s5_b_im, 's5_c_re': s5_c_re, 's5_c_im': s5_c_im,
            's5_d': s5_d, 's5_w_glu': s5_w_glu, 's5_b_glu': s5_b_glu, 's5_w_out': s5_w_out}


def reference(x_prompt, x_sample, state_gla, state_gdn, state_gdn_conv, state_s5_re, state_s5_im,
              ln_g, ln_b, gla_w_in, gla_w_a2, gla_b_a, gla_norm_g, gla_w_out,
              gdn_w_in, gdn_w_conv, gdn_a_log, gdn_dt_bias, gdn_norm_g, gdn_w_out,
              s5_w_in, s5_lam_re, s5_lam_im, s5_log_dt, s5_b_re, s5_b_im, s5_c_re, s5_c_im,
              s5_d, s5_w_glu, s5_b_glu, s5_w_out):
    wts = dict(ln_g=ln_g, ln_b=ln_b,
               gla_w_in=gla_w_in, gla_w_a2=gla_w_a2, gla_b_a=gla_b_a, gla_norm_g=gla_norm_g,
               gla_w_out=gla_w_out,
               gdn_w_in=gdn_w_in, gdn_w_conv=gdn_w_conv, gdn_a_log=gdn_a_log, gdn_dt_bias=gdn_dt_bias,
               gdn_norm_g=gdn_norm_g, gdn_w_out=gdn_w_out,
               s5_w_in=s5_w_in, s5_lam_re=s5_lam_re, s5_lam_im=s5_lam_im, s5_log_dt=s5_log_dt,
               s5_b_re=s5_b_re, s5_b_im=s5_b_im, s5_c_re=s5_c_re, s5_c_im=s5_c_im, s5_d=s5_d,
               s5_w_glu=s5_w_glu, s5_b_glu=s5_b_glu, s5_w_out=s5_w_out)
    bp = x_prompt.shape[0]
    z_gla = jnp.zeros((N_GLA, bp, GLA_HEADS, GLA_DK, GLA_DV), F32)
    z_gdn = jnp.zeros((N_GDN, bp, GDN_HEADS, GDN_DK, GDN_DV), F32)
    z_conv = jnp.zeros((N_GDN, bp, GDN_CONV - 1, GDN_CONV_CH), F32)
    z_s5 = jnp.zeros((N_S5, bp, S5_GROUPS, S5_STATE), F32)
    y_prompt, p_gla, p_gdn, p_gdn_conv, p_s5_re, p_s5_im = trunk(
        x_prompt, z_gla, z_gdn, z_conv, z_s5, z_s5, wts)
    y_sample, s_gla, s_gdn, s_gdn_conv, s_s5_re, s_s5_im = trunk(
        x_sample, state_gla, state_gdn, state_gdn_conv, state_s5_re, state_s5_im, wts)
    return (y_prompt, y_sample, p_gla, p_gdn, p_gdn_conv, p_s5_re, p_s5_im,
            s_gla, s_gdn, s_gdn_conv, s_s5_re, s_s5_im)
```

```cpp
#include <hip/hip_runtime.h>
#include <cstdio>
#include <cstdint>

#define LAS __attribute__((address_space(3)))
#define GAS __attribute__((address_space(1)))
typedef _Float16 f16;
typedef _Float16 h8 __attribute__((ext_vector_type(8)));
typedef _Float16 h4 __attribute__((ext_vector_type(4)));
typedef _Float16 h2 __attribute__((ext_vector_type(2)));
typedef float f32x2 __attribute__((ext_vector_type(2)));
typedef float f32x4 __attribute__((ext_vector_type(4)));
typedef float f32x16 __attribute__((ext_vector_type(16)));
typedef unsigned u32x2 __attribute__((ext_vector_type(2)));
typedef unsigned u32x4 __attribute__((ext_vector_type(4)));
#define DI __device__ __forceinline__
#define MFMA16(a, b, c) __builtin_amdgcn_mfma_f32_16x16x32_f16((a), (b), (c), 0, 0, 0)
#define MFMA32(a, b, c) __builtin_amdgcn_mfma_f32_32x32x16_f16((a), (b), (c), 0, 0, 0)
#define LDS_WAIT() asm volatile("s_waitcnt lgkmcnt(0)" ::: "memory")
#define VM_WAIT() asm volatile("s_waitcnt vmcnt(0)" ::: "memory")

DI unsigned pkh(float lo, float hi) { h2 v; v.x = (f16)lo; v.y = (f16)hi; return __builtin_bit_cast(unsigned, v); }
DI h8 cat44(h4 a, h4 b) { return __builtin_shufflevector(a, b, 0, 1, 2, 3, 4, 5, 6, 7); }
DI float sigmoidf_(float x) { return 1.0f / (1.0f + __expf(-x)); }
DI float siluf_(float x) { return x / (1.0f + __expf(-x)); }

namespace pg8 {
constexpr int BM = 256, BK = 64, HALF = 128, HTB = HALF * BK * 2, STAGE_BYTES = 8 * HTB, NXCD = 8, WGM = 8;
__host__ __device__ __forceinline__ int lds_byte(int r, int c) { const int st = (r >> 4) * 2 + (c >> 5), rr = r & 15, cc = c & 31, ob = rr * 64 + cc * 2; return st * 1024 + (ob ^ (((ob >> 9) & 1) << 5)); }
__host__ __device__ __forceinline__ void stage_rc(int b, int& R, int& C) { const int st = b / 1024, sb = b % 1024, swz = sb ^ (((sb >> 9) & 1) << 5); R = (st >> 1) * 16 + swz / 64; C = (st & 1) * 32 + (swz % 64) / 2; }
__host__ __device__ __forceinline__ int perm32(int rho) { const int n = rho >> 4, i = rho & 15; return 8 * (i >> 2) + 4 * n + (i & 3); }

struct Unit { int pm, pn; };
struct Gemm { const f16* A; const f16* Bt; int M, N, K; };

struct StaticOrder {
    int nM, nN, nwg, G, c;
    __host__ __device__ void init(int M, int N, int G_, int c_) { nM = M / BM; nN = N / BM; nwg = nM * nN; G = G_; c = c_; }
    __host__ __device__ bool next(int i, Unit& u) const {
        const long L = (long)i * G + c; if (L >= nwg) return false;
        int wgid = (int)L; { const int q = nwg / NXCD, r = nwg % NXCD, xcd = wgid % NXCD, off = wgid / NXCD; wgid = (xcd < r ? xcd * (q + 1) : r * (q + 1) + (xcd - r) * q) + off; }
        const int nig = WGM * nN, gid = wgid / nig, fm = gid * WGM, gsz = (nM - fm) < WGM ? (nM - fm) : WGM;
        u.pm = fm + ((wgid % nig) % gsz); u.pn = (wgid % nig) / gsz; return true;
    }
    __device__ __forceinline__ void a_ready(const Unit&) const {}
    __device__ __forceinline__ void done(const Unit&) const {}
};

struct EpiF16 {
    static constexpr bool PERM = true, AFTER_DRAIN = false;
    f16* O; int ldc;
    __device__ __forceinline__ void operator()(const f32x4 (&acc)[2][2][4][2], const Unit& u, int wr, int wc, int fr, int fq) const {
        const int row0 = u.pm * BM + wr * 64 + fr, col0 = u.pn * BM + wc * 32 + 8 * fq;
#pragma unroll
        for (int ai = 0; ai < 2; ++ai)
#pragma unroll
            for (int m = 0; m < 4; ++m) { f16* rowp = O + (size_t)(row0 + ai * HALF + m * 16) * ldc + col0;
#pragma unroll
                for (int bj = 0; bj < 2; ++bj) { const f32x4 v0 = acc[ai][bj][m][0], v1 = acc[ai][bj][m][1];
                    u32x4 w; w.x = pkh(v0[0], v0[1]); w.y = pkh(v0[2], v0[3]); w.z = pkh(v1[0], v1[1]); w.w = pkh(v1[2], v1[3]);
                    *(u32x4*)(rowp + bj * HALF) = w; } }
    }
};
struct EpiF32 {
    static constexpr bool PERM = false, AFTER_DRAIN = false;
    float* C; int ldc;
    __device__ __forceinline__ void operator()(const f32x4 (&acc)[2][2][4][2], const Unit& u, int wr, int wc, int fr, int fq) const {
        const int row0 = u.pm * BM + wr * 64 + fr, col0 = u.pn * BM + wc * 32 + 4 * fq;
#pragma unroll
        for (int ai = 0; ai < 2; ++ai)
#pragma unroll
            for (int m = 0; m < 4; ++m) { float* rowp = C + (size_t)(row0 + ai * HALF + m * 16) * ldc + col0;
#pragma unroll
                for (int bj = 0; bj < 2; ++bj)
#pragma unroll
                    for (int n = 0; n < 2; ++n) *(f32x4*)(rowp + bj * HALF + n * 16) = acc[ai][bj][m][n]; }
    }
};
struct EpiGlu {
    static constexpr bool PERM = true, AFTER_DRAIN = false;
    f16* O; const f16* Z; int ldz; const float* bias;
    __device__ __forceinline__ void operator()(const f32x4 (&acc)[2][2][4][2], const Unit& u, int wr, int wc, int fr, int fq) const {
        const int row0 = u.pm * BM + wr * 64 + fr, col0 = u.pn * HALF + wc * 32 + 8 * fq;
        const f32x4 b10 = *(const f32x4*)(bias + col0), b11 = *(const f32x4*)(bias + col0 + 4), b20 = *(const f32x4*)(bias + 1024 + col0), b21 = *(const f32x4*)(bias + 1024 + col0 + 4);
#pragma unroll
        for (int ai = 0; ai < 2; ++ai)
#pragma unroll
            for (int m = 0; m < 4; ++m) { const int row = row0 + ai * HALF + m * 16;
                const h8 z = *(const h8*)(Z + (size_t)row * ldz + col0);
                const f32x4 y10 = acc[ai][0][m][0] + b10, y11 = acc[ai][0][m][1] + b11, y20 = acc[ai][1][m][0] + b20, y21 = acc[ai][1][m][1] + b21;
                float o[8];
#pragma unroll
                for (int i = 0; i < 4; ++i) { o[i] = y10[i] * sigmoidf_(y20[i]) * siluf_((float)z[i]); o[4 + i] = y11[i] * sigmoidf_(y21[i]) * siluf_((float)z[4 + i]); }
                u32x4 w; w.x = pkh(o[0], o[1]); w.y = pkh(o[2], o[3]); w.z = pkh(o[4], o[5]); w.w = pkh(o[6], o[7]);
                *(u32x4*)(O + (size_t)row * 1024 + col0) = w; }
    }
};

template <class Epi, class Sched, bool ALIGN_EPI = false, bool SP2 = false>
__device__ __forceinline__ void gemm_phase(LAS unsigned char* lds, const Gemm g, const Sched& S, const Epi& E, const int tid) {
    const int wid = __builtin_amdgcn_readfirstlane(tid >> 6), lane = tid & 63, wr = wid >> 2, wc = wid & 3, fr = lane & 15, fq = lane >> 4;
    const int K = g.K, nt = K / BK;
    unsigned voffA[2], voffB[2];
#pragma unroll
    for (int i = 0; i < 2; ++i) { int R, C; stage_rc(tid * 16 + i * 8192, R, C); const int Rb = Epi::PERM ? ((R & ~31) + perm32(R & 31)) : R;
        voffA[i] = (unsigned)(R * K + C) * 2u; voffB[i] = (unsigned)(Rb * K + C) * 2u; }
    const size_t kstep = (size_t)(BK * 2);
    const size_t hstep = (size_t)HALF * K * 2;
    const size_t tstep = 2 * hstep;
    const unsigned ldsw = (unsigned)wid * 1024u;
    const int aoff = lds_byte(wr * 64 + fr, fq * 8), boff = lds_byte(wc * 32 + fr, fq * 8);
#define PG8_SA(b, h) (((b) * 2 + (h)) * HTB)
#define PG8_SB(b, h) ((4 + (b) * 2 + (h)) * HTB)
#define PG8_STAGE(bufoff, gbase, voff) do { _Pragma("unroll") for (int _i = 0; _i < 2; ++_i) \
        __builtin_amdgcn_global_load_lds((const unsigned*)((const char*)(gbase) + (voff)[_i]), (LAS unsigned*)(lds + (bufoff) + ldsw + _i * 8192), 16, 0, 0); } while (0)
#define PG8_LDA(dst, b, h) do { _Pragma("unroll") for (int m = 0; m < 4; ++m) _Pragma("unroll") for (int k = 0; k < 2; ++k) dst[m][k] = *(const LAS h8*)(lds + PG8_SA(b, h) + aoff + m * 2048 + k * 1024); } while (0)
#define PG8_LDB(dst, b, h) do { _Pragma("unroll") for (int n = 0; n < 2; ++n) _Pragma("unroll") for (int k = 0; k < 2; ++k) dst[n][k] = *(const LAS h8*)(lds + PG8_SB(b, h) + boff + n * 2048 + k * 1024); } while (0)
#define PG8_MMA(ai, bj, At, Bt) do { __builtin_amdgcn_s_setprio(1); _Pragma("unroll") for (int m = 0; m < 4; ++m) _Pragma("unroll") for (int n = 0; n < 2; ++n) _Pragma("unroll") for (int k = 0; k < 2; ++k) \
        acc[ai][bj][m][n] = __builtin_amdgcn_mfma_f32_16x16x32_f16(Bt[n][k], At[m][k], acc[ai][bj][m][n], 0, 0, 0); __builtin_amdgcn_s_setprio(0); } while (0)
#define PG8_WAIT_V(n) asm volatile("s_waitcnt vmcnt(" #n ")" ::: "memory")
#define PG8_WAIT_L(n) asm volatile("s_waitcnt lgkmcnt(" #n ")" ::: "memory")
#define PG8_BAR __builtin_amdgcn_s_barrier()
#define PG8_SCHED __builtin_amdgcn_sched_barrier(0)
    Unit cur, nxt; int ui = 0;
    if (!S.next(0, cur)) return;
    f32x4 acc[2][2][4][2];
#pragma unroll
    for (int a = 0; a < 2; ++a)
#pragma unroll
        for (int b = 0; b < 2; ++b)
#pragma unroll
            for (int m = 0; m < 4; ++m)
#pragma unroll
                for (int n = 0; n < 2; ++n) acc[a][b][m][n] = (f32x4){0.f, 0.f, 0.f, 0.f};
    h8 At[4][2], B0[2][2], B1[2][2];
    const char* cA = (const char*)g.A + (size_t)cur.pm * tstep; const char* cB = (const char*)g.Bt + (size_t)cur.pn * tstep;
    S.a_ready(cur);
    if constexpr (SP2) {
        PG8_STAGE(PG8_SB(0, 0), cB, voffB); PG8_STAGE(PG8_SB(0, 1), cB + hstep, voffB); PG8_STAGE(PG8_SA(0, 0), cA, voffA); PG8_STAGE(PG8_SA(0, 1), cA + hstep, voffA);
        if (wr == 1) PG8_BAR;
        PG8_WAIT_V(2); PG8_BAR;
        PG8_STAGE(PG8_SB(1, 0), cB + kstep, voffB); PG8_STAGE(PG8_SA(1, 0), cA + kstep, voffA); PG8_STAGE(PG8_SB(1, 1), cB + hstep + kstep, voffB);
        PG8_WAIT_V(6); PG8_BAR;
    } else {
        PG8_STAGE(PG8_SB(0, 0), cB, voffB); PG8_STAGE(PG8_SA(0, 0), cA, voffA); PG8_STAGE(PG8_SB(0, 1), cB + hstep, voffB); PG8_STAGE(PG8_SA(0, 1), cA + hstep, voffA);
        if (wr == 1) PG8_BAR;
        PG8_WAIT_V(4); PG8_BAR;
        PG8_STAGE(PG8_SB(1, 0), cB + kstep, voffB); PG8_STAGE(PG8_SA(1, 0), cA + kstep, voffA); PG8_STAGE(PG8_SB(1, 1), cB + hstep + kstep, voffB);
        PG8_WAIT_V(6); PG8_BAR;
    }
    for (;;) {
        const bool has_next = S.next(ui + 1, nxt);
        const char* nA = has_next ? (const char*)g.A + (size_t)nxt.pm * tstep : cA; const char* nB = has_next ? (const char*)g.Bt + (size_t)nxt.pn * tstep : cB;
        for (int t = 0; t < nt; t += 2) {
            const bool last = (t == nt - 2);
            const char* a1 = cA + (size_t)(t + 1) * kstep;
            const char* a2 = last ? nA : cA + (size_t)(t + 2) * kstep; const char* b2 = last ? nB : cB + (size_t)(t + 2) * kstep;
            const char* a3 = a2 + kstep; const char* b3 = b2 + kstep;
            if (last && has_next) S.a_ready(nxt);
            if constexpr (SP2) {
            PG8_LDB(B0, 0, 0); PG8_LDB(B1, 0, 1); PG8_SCHED; PG8_LDA(At, 0, 0); PG8_STAGE(PG8_SA(1, 1), a1 + hstep, voffA);
            PG8_WAIT_V(8); PG8_WAIT_L(0); PG8_BAR; PG8_MMA(0, 0, At, B0); PG8_MMA(0, 1, At, B1); PG8_BAR; PG8_SCHED;
            PG8_LDA(At, 0, 1); PG8_STAGE(PG8_SB(0, 0), b2, voffB); PG8_STAGE(PG8_SB(0, 1), b2 + hstep, voffB); PG8_STAGE(PG8_SA(0, 0), a2, voffA);
            PG8_WAIT_V(8); PG8_WAIT_L(0); PG8_BAR; PG8_MMA(1, 0, At, B0); PG8_MMA(1, 1, At, B1); PG8_BAR; PG8_SCHED;
            PG8_LDB(B0, 1, 0); PG8_LDB(B1, 1, 1); PG8_SCHED; PG8_LDA(At, 1, 0); PG8_STAGE(PG8_SA(0, 1), a2 + hstep, voffA);
            PG8_WAIT_V(8); PG8_WAIT_L(0); PG8_BAR; PG8_MMA(0, 0, At, B0); PG8_MMA(0, 1, At, B1); PG8_BAR; PG8_SCHED;
            PG8_LDA(At, 1, 1); PG8_STAGE(PG8_SB(1, 0), b3, voffB); PG8_STAGE(PG8_SB(1, 1), b3 + hstep, voffB); PG8_STAGE(PG8_SA(1, 0), a3, voffA);
            PG8_WAIT_V(8); PG8_WAIT_L(0); PG8_BAR; PG8_MMA(1, 0, At, B0); PG8_MMA(1, 1, At, B1); PG8_BAR; PG8_SCHED;
            } else {
            PG8_LDB(B0, 0, 0); PG8_SCHED; PG8_LDA(At, 0, 0); PG8_STAGE(PG8_SA(1, 1), a1 + hstep, voffA);
            PG8_WAIT_L(8); PG8_BAR; PG8_WAIT_L(0); PG8_MMA(0, 0, At, B0); PG8_BAR; PG8_SCHED;
            PG8_LDB(B1, 0, 1); PG8_STAGE(PG8_SB(0, 0), b2, voffB);
            PG8_BAR; PG8_WAIT_L(0); PG8_MMA(0, 1, At, B1); PG8_BAR;
            PG8_LDA(At, 0, 1); PG8_STAGE(PG8_SA(0, 0), a2, voffA);
            PG8_BAR; PG8_WAIT_L(0); PG8_MMA(1, 0, At, B0); PG8_BAR; PG8_SCHED;
            PG8_STAGE(PG8_SB(0, 1), b2 + hstep, voffB);
            PG8_WAIT_V(6); PG8_BAR; PG8_MMA(1, 1, At, B1); PG8_BAR;
            PG8_LDB(B0, 1, 0); PG8_SCHED; PG8_LDA(At, 1, 0); PG8_STAGE(PG8_SA(0, 1), a2 + hstep, voffA);
            PG8_WAIT_L(8); PG8_BAR; PG8_WAIT_L(0); PG8_MMA(0, 0, At, B0); PG8_BAR; PG8_SCHED;
            PG8_LDB(B1, 1, 1); PG8_STAGE(PG8_SB(1, 0), b3, voffB);
            PG8_BAR; PG8_WAIT_L(0); PG8_MMA(0, 1, At, B1); PG8_BAR;
            PG8_LDA(At, 1, 1); PG8_STAGE(PG8_SA(1, 0), a3, voffA);
            PG8_BAR; PG8_WAIT_L(0); PG8_MMA(1, 0, At, B0); PG8_BAR; PG8_SCHED;
            PG8_STAGE(PG8_SB(1, 1), b3 + hstep, voffB);
            PG8_WAIT_V(6); PG8_BAR; PG8_MMA(1, 1, At, B1); PG8_BAR;
            }
        }
        if constexpr (ALIGN_EPI) { if (wr == 0) PG8_BAR; }
        if constexpr (!Epi::AFTER_DRAIN) { E(acc, cur, wr, wc, fr, fq); S.done(cur); }
        if (!has_next) break;
#pragma unroll
        for (int a = 0; a < 2; ++a)
#pragma unroll
            for (int b = 0; b < 2; ++b)
#pragma unroll
                for (int m = 0; m < 4; ++m)
#pragma unroll
                    for (int n = 0; n < 2; ++n) acc[a][b][m][n] = (f32x4){0.f, 0.f, 0.f, 0.f};
        cur = nxt; cA = nA; cB = nB; ++ui;
        if constexpr (ALIGN_EPI) { if (wr == 1) PG8_BAR; }
    }
    PG8_WAIT_V(0);
    if constexpr (!ALIGN_EPI) { if (wr == 0) PG8_BAR; }
    PG8_BAR;
#undef PG8_SA
#undef PG8_SB
#undef PG8_STAGE
#undef PG8_LDA
#undef PG8_LDB
#undef PG8_MMA
#undef PG8_WAIT_V
#undef PG8_WAIT_L
#undef PG8_BAR
#undef PG8_SCHED
}
}

constexpr int NWAVES = 8, NTHR = 512;
constexpr int DM = 1024;
constexpr int MP = 8 * 2048, MS = 128 * 8, M = MP + MS;
constexpr int GLA_LD = 3328, GDN_LD = 4352, S5_LD = 2048;
constexpr int GLA_IN = 3088, GDN_IN = 4112;
constexpr float ALPHA_RES = 1.681792830507429f;
constexpr float LN_EPS = 1e-5f, NORM_EPS = 1e-6f;

constexpr size_t O_YP = 0, O_YS = O_YP + (size_t)MP * DM, O_PGLA = O_YS + (size_t)MS * DM, O_PGDN = O_PGLA + 2ull * 8 * 4 * 128 * 256, O_PCONV = O_PGDN + 8ull * 8 * 128 * 128,
                 O_PS5R = O_PCONV + 8ull * 3 * 3072, O_PS5I = O_PS5R + 8ull * 64 * 64, O_SGLA = O_PS5I + 8ull * 64 * 64, O_SGDN = O_SGLA + 2ull * 128 * 4 * 128 * 256,
                 O_SCONV = O_SGDN + 128ull * 8 * 128 * 128, O_SS5R = O_SCONV + 128ull * 3 * 3072, O_SS5I = O_SS5R + 128ull * 64 * 64, O_END = O_SS5I + 128ull * 64 * 64;

constexpr size_t MiB = 1u << 20;
constexpr size_t WS_CTL = 0, CTL_ZERO_BYTES = 64 * 1024;
constexpr size_t SZ_WGLAIN = (size_t)GLA_LD * 1024 * 2, SZ_W1K = 1024ull * 1024 * 2, SZ_WGDNIN = (size_t)GDN_LD * 1024 * 2, SZ_W2K = 2048ull * 1024 * 2;
constexpr size_t WS_WGLAIN = 1 * MiB, WS_WGLAOUT = WS_WGLAIN + 2 * SZ_WGLAIN, WS_WGDNIN = WS_WGLAOUT + 2 * SZ_W1K, WS_WGDNOUT = WS_WGDNIN + SZ_WGDNIN,
                 WS_WS5IN = WS_WGDNOUT + SZ_W1K, WS_WS5GLU = WS_WS5IN + SZ_W2K, WS_WS5OUT = WS_WS5GLU + SZ_W2K, WS_WEND = WS_WS5OUT + SZ_W1K;
constexpr size_t WS_X16 = 41 * MiB;
constexpr size_t WS_H = WS_X16 + 34 * MiB;
constexpr size_t WS_OG = WS_H + 145 * MiB;
constexpr size_t WS_CHK = WS_OG + 34 * MiB;
constexpr size_t WS_F = WS_CHK, WS_YG = WS_CHK + 128 * MiB;
constexpr size_t WS_END = WS_CHK + 238 * MiB;
static_assert(WS_WEND <= WS_X16 && WS_END <= 512 * MiB, "d_ws map");
static_assert((size_t)M * 1024 * 2 <= 34 * MiB && (size_t)M * GDN_LD * 2 <= 145 * MiB && (size_t)M * 1024 * 4 <= 128 * MiB, "d_ws sizes");
constexpr int CW_BAR = 1024;

constexpr int GA_ATT = 0, GA_QD = 9216, GA_KET = GA_QD + 17408, GA_VT = GA_KET + 18432, GA_EBL = GA_VT + 36864, GLA_CHK = GA_EBL + 512;
constexpr int GD_ATT = 0, GD_QD = 9216, GD_NW = GD_QD + 17408, GD_KET = GD_NW + 17408, GD_UT = GD_KET + 18432, GD_GE = GD_UT + 18432, GDN_CHK = GD_GE + 64;
static_assert(GLA_CHK % 16 == 0 && GDN_CHK % 16 == 0, "chunk blocks are copied in 16-byte pieces");
static_assert((size_t)1536 * GLA_CHK <= 238 * MiB && (size_t)3072 * GDN_CHK <= 238 * MiB, "chunk area");

constexpr int LDS_BYTES = 163840;
constexpr int LDSCTL_OFF = LDS_BYTES - 256;

#define XB_TMO      128
#define XB_XCNT(j)  (256  + 64 * (j))
#define XB_XSUB(j)  (1280 + 64 * (j))
#define XB_XGEN(j)  (2304 + 64 * (j))
#define XB_TOP      3328
#define XB_TOPGEN   3392
#define XCD_BAR_WORDS 3456
#define XB_SPIN_CAP (1u << 18)
static_assert((CW_BAR + XCD_BAR_WORDS) * 4 <= (int)CTL_ZERO_BYTES, "barrier words inside the memset region");
__device__ __forceinline__ unsigned xb_ld(unsigned* p)              { return __hip_atomic_load(p, __ATOMIC_RELAXED, __HIP_MEMORY_SCOPE_AGENT); }
__device__ __forceinline__ unsigned xb_add(unsigned* p, unsigned v) { return __hip_atomic_fetch_add(p, v, __ATOMIC_RELAXED, __HIP_MEMORY_SCOPE_AGENT); }
__device__ __forceinline__ unsigned xb_xcc_id() { return (unsigned)__builtin_amdgcn_s_getreg((3 << 11) | 20) & 0xFu; }
#define XB_SPIN(cond, bar) do { unsigned _sp = 0; while (cond) { __builtin_amdgcn_s_sleep(1); \
    if ((++_sp & 255u) == 0u) { if (xb_ld(&(bar)[XB_TMO])) break; if (_sp > XB_SPIN_CAP) { atomicAdd(&(bar)[XB_TMO], 1u); break; } } } } while (0)
struct XcdBarrier { unsigned* bar; unsigned x; volatile LAS unsigned* st; };
__device__ __forceinline__ XcdBarrier xcd_barrier_post(unsigned* bar, volatile LAS unsigned* st) {
    XcdBarrier b; b.bar = bar; b.x = xb_xcc_id(); b.st = st;
    if (threadIdx.x == 0) (void)xb_add(&bar[XB_XCNT(b.x)], 1u);
    return b;
}
__device__ __forceinline__ void xcd_barrier_complete(unsigned* bar, unsigned x, unsigned& nloc, unsigned& nx) {
    const unsigned G = gridDim.x * gridDim.y * gridDim.z;
    unsigned sum, cnt, mine, sp = 0u;
    for (;;) {
        sum = 0u; cnt = 0u; mine = 0u;
#pragma unroll
        for (unsigned j = 0; j < 16; ++j) { const unsigned c = xb_ld(&bar[XB_XCNT(j)]); sum += c; cnt += (c > 0u) ? 1u : 0u; mine = (j == x) ? c : mine; }
        if (sum == G) break;
        __builtin_amdgcn_s_sleep(1);
        if ((++sp & 255u) == 0u) { if (xb_ld(&bar[XB_TMO])) break; if (sp > XB_SPIN_CAP) { atomicAdd(&bar[XB_TMO], 1u); break; } }
    }
    nloc = mine > 0u ? mine : 1u; nx = cnt > 0u ? cnt : 1u;
}
__device__ __forceinline__ void xcd_barrier(const XcdBarrier& b) {
    asm volatile("s_waitcnt vmcnt(0)" ::: "memory");
    __syncthreads();
    if (threadIdx.x == 0) {
        unsigned* bar = b.bar;
        __builtin_amdgcn_s_waitcnt(0);
        unsigned nloc = b.st[0], nx = b.st[1];
        if (nloc == 0u) { xcd_barrier_complete(bar, b.x, nloc, nx); b.st[0] = nloc; b.st[1] = nx; }
        const unsigned old = xb_add(&bar[XB_XSUB(b.x)], 1u);
        const unsigned gen = old / nloc;
        if (old + 1u == (gen + 1u) * nloc) {
            __builtin_amdgcn_fence(__ATOMIC_RELEASE, "agent");
            asm volatile("s_waitcnt vmcnt(0)" ::: "memory");
            const unsigned og = xb_add(&bar[XB_TOP], 1u);
            const unsigned tg = og / nx;
            if (og + 1u == (tg + 1u) * nx) xb_add(&bar[XB_TOPGEN], 1u);
            else XB_SPIN(xb_ld(&bar[XB_TOPGEN]) == tg, bar);
            __builtin_amdgcn_fence(__ATOMIC_ACQUIRE, "agent");
            xb_add(&bar[XB_XGEN(b.x)], 1u);
            asm volatile("s_waitcnt vmcnt(0)" ::: "memory");
        } else {
            XB_SPIN(xb_ld(&bar[XB_XGEN(b.x)]) == gen, bar);
            __builtin_amdgcn_fence(__ATOMIC_ACQUIRE, "agent");
            asm volatile("s_waitcnt vmcnt(0)" ::: "memory");
        }
    }
    __syncthreads();
}

struct Args { const float* in[32]; float* out; unsigned char* ws; int ph_lo, ph_hi; };
enum { I_XP = 0, I_XS, I_SGLA, I_SGDN, I_SCONV, I_SS5R, I_SS5I, I_LNG, I_LNB, I_GLA_WIN, I_GLA_WA2, I_GLA_BA, I_GLA_NG, I_GLA_WOUT,
       I_GDN_WIN, I_GDN_WCONV, I_GDN_ALOG, I_GDN_DTB, I_GDN_NG, I_GDN_WOUT, I_S5_WIN, I_S5_LRE, I_S5_LIM, I_S5_LDT, I_S5_BRE, I_S5_BIM, I_S5_CRE, I_S5_CIM,
       I_S5_D, I_S5_WGLU, I_S5_BGLU, I_S5_WOUT };
struct Frame {
    LAS unsigned char* lds;
    int tid, lane, wave, G, bid;
    const Args* a;
    unsigned char* ws; float* out;
};
DI float wave_sum(float v) {
#pragma unroll
    for (int o = 1; o < 64; o <<= 1) v += __shfl_xor(v, o);
    return v;
}

DI void p0_transpose_item(const float* W, int N, f16* WT, LAS float* scr, int item, int nblk, int lane, int glu) {
    const int kb = item / nblk, nb = item % nblk, k0 = 64 * kb, n0 = 32 * nb;
    const int nn = n0 + (lane & 31);
#pragma unroll 8
    for (int i = 0; i < 32; ++i) { const int kk = 2 * i + (lane >> 5); scr[kk * 33 + (lane & 31)] = (nn < N) ? W[(size_t)(k0 + kk) * N + nn] : 0.f; }
    LDS_WAIT(); asm volatile("" ::: "memory");
    const int c = lane & 7;
#pragma unroll
    for (int j = 0; j < 4; ++j) { const int n = (lane >> 3) + 8 * j; const LAS float* s = scr + (8 * c) * 33 + n;
        u32x4 o; o.x = pkh(s[0 * 33], s[1 * 33]); o.y = pkh(s[2 * 33], s[3 * 33]); o.z = pkh(s[4 * 33], s[5 * 33]); o.w = pkh(s[6 * 33], s[7 * 33]);
        int row = n0 + n;
        if (glu) { const int jj = row & 1023; row = 256 * (jj >> 7) + (row >= 1024 ? 128 : 0) + (jj & 127); }
        *(GAS u32x4*)(WT + (size_t)row * 1024 + k0 + 8 * c) = o; }
    LDS_WAIT(); asm volatile("" ::: "memory");
}
DI void p0_prologue(Frame& F) {
    LAS float* scr = (LAS float*)(F.lds + F.wave * 16384);
    const int gw = F.bid * NWAVES + F.wave, NGW = F.G * NWAVES;
    const Args& A = *F.a;
    constexpr int NB_GLA = GLA_LD / 32, NB_GDN = GDN_LD / 32;
    constexpr int I0 = 16 * NB_GLA, I1 = 16 * 32, I2 = 16 * NB_GDN, I3 = 16 * 64;
    constexpr int NITEMS = 2 * I0 + 2 * I1 + I2 + I1 + I3 + I3 + I1;
    for (int it = gw; it < NITEMS; it += NGW) {
        int r = it;
        if (r < 2 * I0) { const int j = r / I0; p0_transpose_item(A.in[I_GLA_WIN] + (size_t)j * 1024 * GLA_IN, GLA_IN, (f16*)(F.ws + WS_WGLAIN + j * SZ_WGLAIN), scr, r % I0, NB_GLA, F.lane, 0); continue; } r -= 2 * I0;
        if (r < 2 * I1) { const int j = r / I1; p0_transpose_item(A.in[I_GLA_WOUT] + (size_t)j * 1024 * 1024, 1024, (f16*)(F.ws + WS_WGLAOUT + j * SZ_W1K), scr, r % I1, 32, F.lane, 0); continue; } r -= 2 * I1;
        if (r < I2) { p0_transpose_item(A.in[I_GDN_WIN], GDN_IN, (f16*)(F.ws + WS_WGDNIN), scr, r, NB_GDN, F.lane, 0); continue; } r -= I2;
        if (r < I1) { p0_transpose_item(A.in[I_GDN_WOUT], 1024, (f16*)(F.ws + WS_WGDNOUT), scr, r, 32, F.lane, 0); continue; } r -= I1;
        if (r < I3) { p0_transpose_item(A.in[I_S5_WIN], 2048, (f16*)(F.ws + WS_WS5IN), scr, r, 64, F.lane, 0); continue; } r -= I3;
        if (r < I3) { p0_transpose_item(A.in[I_S5_WGLU], 2048, (f16*)(F.ws + WS_WS5GLU), scr, r, 64, F.lane, 1); continue; } r -= I3;
        p0_transpose_item(A.in[I_S5_WOUT], 1024, (f16*)(F.ws + WS_WS5OUT), scr, r, 32, F.lane, 0);
    }
    f16* X16 = (f16*)(F.ws + WS_X16);
    for (int m = gw; m < M; m += NGW) {
        const float* xr = (m < MP) ? A.in[I_XP] + (size_t)m * DM : A.in[I_XS] + (size_t)(m - MP) * DM;
        const GAS f32x4* x4 = (const GAS f32x4*)xr + F.lane;
        GAS u32x2* o8 = (GAS u32x2*)(X16 + (size_t)m * DM) + F.lane;
#pragma unroll
        for (int j = 0; j < 4; ++j) { const f32x4 v = x4[64 * j]; u32x2 o; o.x = pkh(v.x, v.y); o.y = pkh(v.z, v.w); o8[64 * j] = o; }
    }
}

DI void ln_phase(Frame& F, int layer, bool final_out) {
    const int gw = F.bid * NWAVES + F.wave, NGW = F.G * NWAVES;
    f16* X16 = (f16*)(F.ws + WS_X16); const float* Fb = (const float*)(F.ws + WS_F);
    const float* g = F.a->in[I_LNG] + layer * DM; const float* bb = F.a->in[I_LNB] + layer * DM;
    f32x4 gv[4], bv[4];
#pragma unroll
    for (int j = 0; j < 4; ++j) { gv[j] = *(const f32x4*)(g + 4 * F.lane + 256 * j); bv[j] = *(const f32x4*)(bb + 4 * F.lane + 256 * j); }
    for (int m = gw; m < M; m += NGW) {
        f32x4 v[4]; float s = 0.f;
#pragma unroll
        for (int j = 0; j < 4; ++j) { const f32x4 f = *(const GAS f32x4*)(Fb + (size_t)m * DM + 4 * F.lane + 256 * j); const h4 x = *(const GAS h4*)(X16 + (size_t)m * DM + 4 * F.lane + 256 * j);
            v[j].x = ALPHA_RES * (float)x.x + f.x; v[j].y = ALPHA_RES * (float)x.y + f.y; v[j].z = ALPHA_RES * (float)x.z + f.z; v[j].w = ALPHA_RES * (float)x.w + f.w;
            s += (v[j].x + v[j].y) + (v[j].z + v[j].w); }
        const float mean = wave_sum(s) * (1.f / DM); float s2 = 0.f;
#pragma unroll
        for (int j = 0; j < 4; ++j) { v[j] = v[j] - mean; s2 += (v[j].x * v[j].x + v[j].y * v[j].y) + (v[j].z * v[j].z + v[j].w * v[j].w); }
        const float rstd = 1.f / sqrtf(wave_sum(s2) * (1.f / DM) + LN_EPS);
#pragma unroll
        for (int j = 0; j < 4; ++j) { const f32x4 o = v[j] * rstd * gv[j] + bv[j];
            if (final_out) *(GAS f32x4*)(F.out + (size_t)m * DM + 4 * F.lane + 256 * j) = o;
            else { u32x2 w; w.x = pkh(o.x, o.y); w.y = pkh(o.z, o.w); *(GAS u32x2*)(X16 + (size_t)m * DM + 4 * F.lane + 256 * j) = w; } }
    }
}

DI void gla_pre_item(Frame& F, int j, int item) {
    LAS unsigned char* L = F.lds;
    LAS f16* ATT = (LAS f16*)(L + GA_ATT); LAS f16* QD = (LAS f16*)(L + GA_QD); LAS f16* KET = (LAS f16*)(L + GA_KET); LAS f16* VT = (LAS f16*)(L + GA_VT); LAS float* EBL = (LAS float*)(L + GA_EBL);
    LAS f16* KI = (LAS f16*)(L + GLA_CHK); LAS float* LR = (LAS float*)(L + GLA_CHK + 17408); LAS float* WA2 = LR + 1024; LAS float* PSUM = WA2 + 2048; LAS float* BC = PSUM + 512;
    int row0, nvalid, h;
    if (item < 1024) { const int b = item >> 7, n = (item >> 2) & 31; h = item & 3; row0 = b * 2048 + n * 64; nvalid = 64; }
    else { const int s = item - 1024; h = s & 3; row0 = MP + (s >> 2) * 8; nvalid = 8; }
    const f16* Hb = (const f16*)(F.ws + WS_H) + (size_t)row0 * GLA_LD;
    const float* wa2 = F.a->in[I_GLA_WA2] + (size_t)j * 16 * 512; const float* ba = F.a->in[I_GLA_BA] + j * 512;
    int tid = F.tid; asm volatile("" : "+v"(tid));
    for (int idx = tid; idx < 1024; idx += NTHR) { const int t = idx >> 4, r = idx & 15; LR[idx] = (t < nvalid) ? (float)Hb[(size_t)t * GLA_LD + 3072 + r] : 0.f; }
    for (int idx = tid; idx < 2048; idx += NTHR) { const int r = idx >> 7, d = idx & 127; WA2[idx] = wa2[r * 512 + h * 128 + d]; }
    __syncthreads();
    const int d = tid & 127, tq = tid >> 7;
    {
        float wreg[16];
#pragma unroll
        for (int r = 0; r < 16; ++r) wreg[r] = WA2[r * 128 + d];
        const float bad = ba[h * 128 + d];
        float run = 0.f;
#pragma unroll 2
        for (int i = 0; i < 16; ++i) { const int t = tq * 16 + i; float x = bad;
#pragma unroll
            for (int r = 0; r < 16; ++r) x += LR[t * 16 + r] * wreg[r];
            const float ls = fminf(x, 0.f) - __logf(1.f + __expf(-fabsf(x)));
            run += (t < nvalid) ? ls * (1.f / 16.f) : 0.f; BC[t * 128 + d] = run; }
        PSUM[tq * 128 + d] = run;
    }
    __syncthreads();
    float pre = 0.f, tot = 0.f;
#pragma unroll
    for (int q = 0; q < 4; ++q) { const float p = PSUM[q * 128 + d]; tot += p; pre += (q < tq) ? p : 0.f; }
    {
        const f16* hq = Hb + (size_t)(tq * 16) * GLA_LD + h * 128 + d;
#pragma unroll 2
        for (int i = 0; i < 16; ++i) { const int t = tq * 16 + i; const float b = pre + BC[t * 128 + d]; const bool ok = t < nvalid;
            const float q = ok ? (float)hq[0] : 0.f, k = ok ? (float)hq[512] : 0.f; hq += GLA_LD;
            QD[t * 136 + d] = (f16)(q * 0.08838834764831845f * __expf(b)); KI[t * 136 + d] = (f16)(k * __expf(-b)); KET[d * 72 + t] = (f16)(k * __expf(tot - b)); }
        if (tq == 0) EBL[d] = __expf(tot);
    }
    {
        const int c = tid & 255, th = tid >> 8; const f16* hv = Hb + (size_t)(th * 32) * GLA_LD + 1024 + h * 256 + c;
#pragma unroll 1
        for (int g8 = 0; g8 < 4; ++g8) { h8 vv;
#pragma unroll
            for (int e = 0; e < 8; ++e) { const int t = th * 32 + g8 * 8 + e; vv[e] = (t < nvalid) ? hv[0] : (f16)0.f; hv += GLA_LD; }
            *(LAS h8*)(VT + c * 72 + th * 32 + 8 * g8) = vv; }
    }
    __syncthreads();
    {
        const int lane = tid & 63, fr = lane & 15, fq = lane >> 4;
#pragma unroll
        for (int tl = 0; tl < 2; ++tl) { const int tile = 2 * F.wave + tl, ti = tile >> 2, tj = tile & 3; f32x4 acc = {0.f, 0.f, 0.f, 0.f};
#pragma unroll
            for (int kk = 0; kk < 4; ++kk) { const h8 a = *(const LAS h8*)(QD + (ti * 16 + fr) * 136 + kk * 32 + 8 * fq), b = *(const LAS h8*)(KI + (tj * 16 + fr) * 136 + kk * 32 + 8 * fq); acc = MFMA16(a, b, acc); }
#pragma unroll
            for (int r = 0; r < 4; ++r) { const int i = ti * 16 + 4 * fq + r, jj = tj * 16 + fr; ATT[i * 72 + jj] = (f16)((jj <= i) ? acc[r] : 0.f); } }
    }
    __syncthreads();
    GAS u32x4* dst = (GAS u32x4*)(F.ws + WS_CHK + (size_t)item * GLA_CHK);
    for (int idx = tid; idx < GLA_CHK / 16; idx += NTHR) dst[idx] = ((const LAS u32x4*)L)[idx];
    __syncthreads();
}

constexpr int GA_OT = GLA_CHK;
DI void gla_scan_seq(Frame& F, int j, int h, int blk0, int bstride, int nchunks, int row0, int nvalid, const float* S0, float* Sout) {
    LAS unsigned char* L = F.lds;
    const LAS f16* ATT = (const LAS f16*)(L + GA_ATT); const LAS f16* QD = (const LAS f16*)(L + GA_QD); const LAS f16* KET = (const LAS f16*)(L + GA_KET); const LAS f16* VT = (const LAS f16*)(L + GA_VT); const LAS float* EBL = (const LAS float*)(L + GA_EBL);
    LAS f16* OT = (LAS f16*)(L + GA_OT);
    const f16* Hb = (const f16*)(F.ws + WS_H); f16* OG = (f16*)(F.ws + WS_OG);
    const float* gnp = F.a->in[I_GLA_NG] + j * 256;
    f32x16 S[4];
    {
        const int lane = F.lane, l31 = lane & 31, hh = lane >> 5, c = 32 * F.wave + l31;
#pragma unroll
        for (int dt = 0; dt < 4; ++dt)
#pragma unroll
            for (int r = 0; r < 16; ++r) { const int d = 32 * dt + (r & 3) + 8 * (r >> 2) + 4 * hh; S[dt][r] = S0 ? S0[(size_t)d * 256 + c] : 0.f; }
    }
#pragma unroll 1
    for (int n = 0; n < nchunks; ++n) {
        int tid = F.tid; asm volatile("" : "+v"(tid));
        const int lane = tid & 63, w = F.wave, l31 = lane & 31, hh = lane >> 5, c = 32 * w + l31;
        const GAS u32x4* src = (const GAS u32x4*)(F.ws + WS_CHK + (size_t)(blk0 + n * bstride) * GLA_CHK);
        for (int idx = tid; idx < GLA_CHK / 16; idx += NTHR) ((LAS u32x4*)L)[idx] = src[idx];
        __syncthreads();
        f32x16 o[2];
#pragma unroll
        for (int it = 0; it < 2; ++it)
#pragma unroll
            for (int r = 0; r < 16; ++r) o[it][r] = 0.f;
#pragma unroll
        for (int dt = 0; dt < 4; ++dt)
#pragma unroll
            for (int s = 0; s < 2; ++s) { h8 sb;
#pragma unroll
                for (int e = 0; e < 8; ++e) sb[e] = (f16)S[dt][8 * s + e];
#pragma unroll
                for (int it = 0; it < 2; ++it) { const LAS f16* p = QD + (32 * it + l31) * 136 + 32 * dt + 16 * s + 4 * hh;
                    const h8 a = cat44(*(const LAS h4*)p, *(const LAS h4*)(p + 8)); o[it] = MFMA32(a, sb, o[it]); } }
        h8 vb[4];
#pragma unroll
        for (int ks = 0; ks < 4; ++ks) vb[ks] = *(const LAS h8*)(VT + c * 72 + 16 * ks + 8 * hh);
#pragma unroll
        for (int ks = 0; ks < 4; ++ks)
#pragma unroll
            for (int it = 0; it < 2; ++it) { const h8 a = *(const LAS h8*)(ATT + (32 * it + l31) * 72 + 16 * ks + 8 * hh); o[it] = MFMA32(a, vb[ks], o[it]); }
#pragma unroll
        for (int it = 0; it < 2; ++it)
#pragma unroll
            for (int r = 0; r < 16; ++r) OT[(32 * it + (r & 3) + 8 * (r >> 2) + 4 * hh) * 264 + c] = (f16)o[it][r];
#pragma unroll
        for (int dt = 0; dt < 4; ++dt) {
#pragma unroll
            for (int r = 0; r < 16; ++r) S[dt][r] *= EBL[32 * dt + (r & 3) + 8 * (r >> 2) + 4 * hh];
#pragma unroll
            for (int ks = 0; ks < 4; ++ks) { const h8 a = *(const LAS h8*)(KET + (32 * dt + l31) * 72 + 16 * ks + 8 * hh); S[dt] = MFMA32(a, vb[ks], S[dt]); } }
        __syncthreads();
        {
            const int t = tid >> 3, c0 = (tid & 7) * 32;
            h8 ov[4]; float ss = 0.f;
#pragma unroll
            for (int i = 0; i < 4; ++i) { ov[i] = *(const LAS h8*)(OT + t * 264 + c0 + 8 * i);
#pragma unroll
                for (int e = 0; e < 8; ++e) { const float v = (float)ov[i][e]; ss += v * v; } }
            ss += __shfl_xor(ss, 1); ss += __shfl_xor(ss, 2); ss += __shfl_xor(ss, 4);
            const float rstd = 1.f / sqrtf(ss * (1.f / 256.f) + NORM_EPS);
            if (t < nvalid) { const size_t row = (size_t)row0 + n * 64 + t;
#pragma unroll
                for (int i = 0; i < 4; ++i) { const h8 rr = *(const GAS h8*)(Hb + row * GLA_LD + 2048 + h * 256 + c0 + 8 * i);
                    const f32x4 g0 = *(const f32x4*)(gnp + c0 + 8 * i), g1 = *(const f32x4*)(gnp + c0 + 8 * i + 4);
                    float ov_[8];
#pragma unroll
                    for (int e = 0; e < 8; ++e) ov_[e] = (float)ov[i][e] * rstd * (e < 4 ? g0[e] : g1[e - 4]) * siluf_((float)rr[e]);
                    u32x4 wv; wv.x = pkh(ov_[0], ov_[1]); wv.y = pkh(ov_[2], ov_[3]); wv.z = pkh(ov_[4], ov_[5]); wv.w = pkh(ov_[6], ov_[7]);
                    *(GAS u32x4*)(OG + row * DM + h * 256 + c0 + 8 * i) = wv; } }
        }
        __syncthreads();
    }
    {
        const int lane = F.lane, l31 = lane & 31, hh = lane >> 5, c = 32 * F.wave + l31;
#pragma unroll
        for (int dt = 0; dt < 4; ++dt)
#pragma unroll
            for (int r = 0; r < 16; ++r) { const int d = 32 * dt + (r & 3) + 8 * (r >> 2) + 4 * hh; Sout[(size_t)d * 256 + c] = S[dt][r]; }
    }
}
DI void gla_pre_phase(Frame& F, int j) { for (int it = F.bid; it < 1536; it += F.G) gla_pre_item(F, j, it); }
DI void gla_scan_phase(Frame& F, int j) {
    const float* S0all = F.a->in[I_SGLA] + (size_t)j * 128 * 4 * 128 * 256;
    float* pout = F.out + O_PGLA + (size_t)j * 8 * 4 * 128 * 256; float* sout = F.out + O_SGLA + (size_t)j * 128 * 4 * 128 * 256;
    if (F.bid < 32 && F.bid < F.G) { const int b = F.bid >> 2, h = F.bid & 3; gla_scan_seq(F, j, h, b * 128 + h, 4, 32, b * 2048, 64, nullptr, pout + (size_t)(b * 4 + h) * 128 * 256); }
    const int first = (F.G > 64) ? 32 : 0, nw = F.G - first;
    if (F.bid >= first) for (int s = F.bid - first; s < 512; s += nw) { const int b = s >> 2, h = s & 3;
        gla_scan_seq(F, j, h, 1024 + s, 0, 1, MP + b * 8, 8, S0all + (size_t)s * 128 * 256, sout + (size_t)s * 128 * 256); }
}

constexpr int GD_KN = GDN_CHK, GD_QN = GD_KN + 18432, GD_AMAT = GD_QN + 18432, GD_P = GD_AMAT + 64 * 68 * 4, GD_TM = GD_P + 4096, GD_SC = GD_TM + 9216;
static_assert(GD_SC + 1024 <= LDSCTL_OFF, "GDN pre-phase LDS");
DI float softplusf_(float x) { return fmaxf(x, 0.f) + __logf(1.f + __expf(-fabsf(x))); }

DI void gdn_pre_item(Frame& F, int item) {
    LAS unsigned char* L = F.lds;
    LAS f16* ATT = (LAS f16*)(L + GD_ATT); LAS f16* QD = (LAS f16*)(L + GD_QD); LAS f16* NW = (LAS f16*)(L + GD_NW); LAS f16* KET = (LAS f16*)(L + GD_KET); LAS f16* UT = (LAS f16*)(L + GD_UT);
    LAS float* GEp = (LAS float*)(L + GD_GE);
    LAS f16* KN = (LAS f16*)(L + GD_KN); LAS f16* QN = (LAS f16*)(L + GD_QN); LAS f16* R2T = KN; LAS f16* R1T = QN;
    LAS float* AMAT = (LAS float*)(L + GD_AMAT); LAS float* TI = (LAS float*)(L + GD_UT); LAS float* P = (LAS float*)(L + GD_P); LAS f16* TM = (LAS f16*)(L + GD_TM);
    LAS float* Gs = (LAS float*)(L + GD_SC); LAS float* BETA = Gs + 64; LAS float* GC = Gs + 128; LAS float* SB2 = Gs + 192;
    int row0, nvalid, h, first, bs = 0;
    if (item < 2048) { const int b = item >> 8, n = (item >> 3) & 31; h = item & 7; row0 = b * 2048 + n * 64; nvalid = 64; first = (n == 0); }
    else { const int s = item - 2048; h = s & 7; bs = s >> 3; row0 = MP + bs * 8; nvalid = 8; first = 2; }
    const f16* Hb = (const f16*)(F.ws + WS_H) + (size_t)row0 * GDN_LD;
    const float* wconv = F.a->in[I_GDN_WCONV]; const float* conv0 = F.a->in[I_SCONV] + (size_t)bs * 3 * 3072;
    int tid = F.tid; asm volatile("" : "+v"(tid));
    const int t = tid >> 3, dseg = tid & 7, d0 = dseg * 16;
    const int lane = tid & 63, fr = lane & 15, fq = lane >> 4;
    float qv[16], kv[16], vv[16];
    {
#pragma unroll
        for (int X = 0; X < 3; ++X) {
            const int col = X * 1024 + h * 128 + d0;
            float acc[16];
#pragma unroll
            for (int e = 0; e < 16; ++e) acc[e] = 0.f;
            if (t < nvalid) {
#pragma unroll
            for (int i = 0; i < 4; ++i) { const int tp = t - 3 + i;
                float xr[16];
                if (tp >= 0 || first == 0) { const h8 a = *(const GAS h8*)(Hb + (ptrdiff_t)tp * GDN_LD + col), b = *(const GAS h8*)(Hb + (ptrdiff_t)tp * GDN_LD + col + 8);
#pragma unroll
                    for (int e = 0; e < 8; ++e) { xr[e] = (float)a[e]; xr[8 + e] = (float)b[e]; } }
                else if (first == 2) {
#pragma unroll
                    for (int e = 0; e < 16; ++e) xr[e] = conv0[(size_t)(3 + tp) * 3072 + col + e]; }
                else {
#pragma unroll
                    for (int e = 0; e < 16; ++e) xr[e] = 0.f; }
#pragma unroll
                for (int e = 0; e < 16; ++e) acc[e] += wconv[(size_t)i * 3072 + col + e] * xr[e];
                asm volatile("" ::: "memory"); }
            }
            const bool ok = t < nvalid;
#pragma unroll
            for (int e = 0; e < 16; ++e) { const float s = ok ? siluf_(acc[e]) : 0.f; if (X == 0) qv[e] = s; else if (X == 1) kv[e] = s; else vv[e] = s; }
        }
        float sq = 0.f, sk = 0.f;
#pragma unroll
        for (int e = 0; e < 16; ++e) { sq += qv[e] * qv[e]; sk += kv[e] * kv[e]; }
        sq += __shfl_xor(sq, 1); sq += __shfl_xor(sq, 2); sq += __shfl_xor(sq, 4);
        sk += __shfl_xor(sk, 1); sk += __shfl_xor(sk, 2); sk += __shfl_xor(sk, 4);
        const float rq = 0.08838834764831845f / sqrtf(sq + NORM_EPS), rk = 1.f / sqrtf(sk + NORM_EPS);
        u32x4 pq[2], pk[2];
#pragma unroll
        for (int e = 0; e < 16; ++e) { qv[e] *= rq; kv[e] *= rk; }
#pragma unroll
        for (int e = 0; e < 4; ++e) { pq[0][e] = pkh(qv[2 * e], qv[2 * e + 1]); pq[1][e] = pkh(qv[8 + 2 * e], qv[8 + 2 * e + 1]); pk[0][e] = pkh(kv[2 * e], kv[2 * e + 1]); pk[1][e] = pkh(kv[8 + 2 * e], kv[8 + 2 * e + 1]); }
        *(LAS u32x4*)(QN + t * 136 + d0) = pq[0]; *(LAS u32x4*)(QN + t * 136 + d0 + 8) = pq[1];
        *(LAS u32x4*)(KN + t * 136 + d0) = pk[0]; *(LAS u32x4*)(KN + t * 136 + d0 + 8) = pk[1];
        if (dseg == 0) { float g = 0.f, be = 0.f;
            if (t < nvalid) { const float a = (float)Hb[(size_t)t * GDN_LD + 4096 + h], bb = (float)Hb[(size_t)t * GDN_LD + 4104 + h];
                g = -__expf(F.a->in[I_GDN_ALOG][h]) * softplusf_(a + F.a->in[I_GDN_DTB][h]); be = sigmoidf_(bb); }
            Gs[t] = g; BETA[t] = be; }
    }
    __syncthreads();
    if (tid < 64) { float v = Gs[tid];
#pragma unroll
        for (int o = 1; o < 64; o <<= 1) { const float u = __shfl_up(v, o); if (tid >= o) v += u; }
        GC[tid] = v; SB2[tid] = BETA[tid] * __expf(v);
        if (tid == 63) GEp[0] = __expf(v); }
    __syncthreads();
    {
#pragma unroll
        for (int tl = 0; tl < 2; ++tl) { const int tile = 2 * F.wave + tl, ti = tile >> 2, tj = tile & 3; f32x4 akk = {0.f, 0.f, 0.f, 0.f}, aqk = {0.f, 0.f, 0.f, 0.f};
#pragma unroll
            for (int kk = 0; kk < 4; ++kk) { const h8 b = *(const LAS h8*)(KN + (tj * 16 + fr) * 136 + kk * 32 + 8 * fq);
                const h8 a1 = *(const LAS h8*)(KN + (ti * 16 + fr) * 136 + kk * 32 + 8 * fq), a2 = *(const LAS h8*)(QN + (ti * 16 + fr) * 136 + kk * 32 + 8 * fq);
                akk = MFMA16(a1, b, akk); aqk = MFMA16(a2, b, aqk); }
#pragma unroll
            for (int r = 0; r < 4; ++r) { const int i = ti * 16 + 4 * fq + r, jj = tj * 16 + fr; const float dec = (jj <= i) ? __expf(GC[i] - GC[jj]) : 0.f;
                AMAT[i * 68 + jj] = (jj < i) ? BETA[i] * akk[r] * dec : 0.f; ATT[i * 72 + jj] = (f16)(aqk[r] * dec); } }
        const float eg = __expf(GC[t]), ee = __expf(GC[63] - GC[t]);
        u32x4 pq[2];
#pragma unroll
        for (int e = 0; e < 4; ++e) { pq[0][e] = pkh(qv[2 * e] * eg, qv[2 * e + 1] * eg); pq[1][e] = pkh(qv[8 + 2 * e] * eg, qv[8 + 2 * e + 1] * eg); }
        *(LAS u32x4*)(QD + t * 136 + d0) = pq[0]; *(LAS u32x4*)(QD + t * 136 + d0 + 8) = pq[1];
#pragma unroll
        for (int e = 0; e < 16; ++e) KET[(d0 + e) * 72 + t] = (f16)(kv[e] * ee);
    }
    __syncthreads();
    {
        const float b1 = BETA[t], b2 = SB2[t];
#pragma unroll
        for (int e = 0; e < 16; ++e) { R1T[(d0 + e) * 72 + t] = (f16)(b1 * vv[e]); R2T[(d0 + e) * 72 + t] = (f16)(b2 * kv[e]); }
        if (tid < 64) {
            const int bI = tid >> 4, cc = tid & 15; float x[16];
#pragma unroll
            for (int i = 0; i < 16; ++i) { float acc = (i == cc) ? 1.f : 0.f;
#pragma unroll
                for (int jj = 0; jj < i; ++jj) acc -= AMAT[(16 * bI + i) * 68 + 16 * bI + jj] * x[jj];
                x[i] = acc; }
#pragma unroll
            for (int i = 0; i < 16; ++i) TI[(16 * bI + i) * 68 + 16 * bI + cc] = x[i];
        }
    }
    __syncthreads();
    {
        const int pr = tid >> 8, i = (tid >> 4) & 15, cc = tid & 15, rb = 32 * pr; float acc = 0.f;
#pragma unroll
        for (int k = 0; k < 16; ++k) acc += AMAT[(rb + 16 + i) * 68 + rb + k] * TI[(rb + k) * 68 + rb + cc];
        P[pr * 256 + i * 16 + cc] = acc;
        __syncthreads();
        float q = 0.f;
#pragma unroll
        for (int k = 0; k < 16; ++k) q -= TI[(rb + 16 + i) * 68 + rb + 16 + k] * P[pr * 256 + k * 16 + cc];
        TI[(rb + 16 + i) * 68 + rb + cc] = q;
    }
    __syncthreads();
    {
        const int i = tid >> 4, c2 = (tid & 15) * 2;
        float a0 = 0.f, a1 = 0.f;
#pragma unroll 8
        for (int k = 0; k < 32; ++k) { const float a = AMAT[(32 + i) * 68 + k]; a0 += (k >= c2) ? a * TI[k * 68 + c2] : 0.f; a1 += (k >= c2 + 1) ? a * TI[k * 68 + c2 + 1] : 0.f; }
        P[i * 32 + c2] = a0; P[i * 32 + c2 + 1] = a1;
        __syncthreads();
        float q0 = 0.f, q1 = 0.f;
#pragma unroll 8
        for (int k = 0; k < 32; ++k) { const float tv = (k <= i) ? TI[(32 + i) * 68 + 32 + k] : 0.f; q0 -= tv * P[k * 32 + c2]; q1 -= tv * P[k * 32 + c2 + 1]; }
        TI[(32 + i) * 68 + c2] = q0; TI[(32 + i) * 68 + c2 + 1] = q1;
    }
    __syncthreads();
    for (int idx = tid; idx < 4096; idx += NTHR) { const int i = idx >> 6, jj = idx & 63; TM[i * 72 + jj] = (f16)((jj <= i) ? TI[i * 68 + jj] : 0.f); }
    __syncthreads();
    {
#pragma unroll
        for (int cl = 0; cl < 2; ++cl) { const int ct = 2 * F.wave + cl; const bool isw = ct >= 8; const LAS f16* RT = isw ? R2T : R1T; const int cb = (ct & 7) * 16;
            h8 bf[2];
#pragma unroll
            for (int k2 = 0; k2 < 2; ++k2) bf[k2] = *(const LAS h8*)(RT + (cb + fr) * 72 + 32 * k2 + 8 * fq);
#pragma unroll
            for (int tt = 0; tt < 4; ++tt) { f32x4 acc = {0.f, 0.f, 0.f, 0.f};
#pragma unroll
                for (int k2 = 0; k2 < 2; ++k2) { const h8 a = *(const LAS h8*)(TM + (16 * tt + fr) * 72 + 32 * k2 + 8 * fq); acc = MFMA16(a, bf[k2], acc); }
                if (!isw) { u32x2 o; o.x = pkh(acc[0], acc[1]); o.y = pkh(acc[2], acc[3]); *(LAS u32x2*)(UT + (cb + fr) * 72 + 16 * tt + 4 * fq) = o; }
                else {
#pragma unroll
                    for (int r = 0; r < 4; ++r) NW[(16 * tt + 4 * fq + r) * 136 + cb + fr] = (f16)(-acc[r]); } } }
    }
    __syncthreads();
    GAS u32x4* dst = (GAS u32x4*)(F.ws + WS_CHK + (size_t)item * GDN_CHK);
    for (int idx = tid; idx < GDN_CHK / 16; idx += NTHR) dst[idx] = ((const LAS u32x4*)L)[idx];
    __syncthreads();
}

constexpr int GD_OT = GDN_CHK;
DI void gdn_scan_seq(Frame& F, int h, int blk0, int bstride, int nchunks, int row0, int nvalid, const float* S0, float* Sout) {
    LAS unsigned char* L = F.lds;
    const LAS f16* ATT = (const LAS f16*)(L + GD_ATT); const LAS f16* QD = (const LAS f16*)(L + GD_QD); const LAS f16* NW = (const LAS f16*)(L + GD_NW); const LAS f16* KET = (const LAS f16*)(L + GD_KET); const LAS f16* UT = (const LAS f16*)(L + GD_UT);
    const LAS float* GEp = (const LAS float*)(L + GD_GE);
    LAS f16* OT = (LAS f16*)(L + GD_OT);
    const f16* Hb = (const f16*)(F.ws + WS_H); f16* OG = (f16*)(F.ws + WS_OG);
    const float* gnp = F.a->in[I_GDN_NG];
    f32x4 S[8];
    {
        const int lane = F.lane, fr = lane & 15, fq = lane >> 4, c = 16 * F.wave + fr;
#pragma unroll
        for (int dt = 0; dt < 8; ++dt)
#pragma unroll
            for (int r = 0; r < 4; ++r) { const int d = 16 * dt + 4 * fq + r; S[dt][r] = S0 ? S0[(size_t)d * 128 + c] : 0.f; }
    }
#pragma unroll 1
    for (int n = 0; n < nchunks; ++n) {
        int tid = F.tid; asm volatile("" : "+v"(tid));
        const int lane = tid & 63, w = F.wave, fr = lane & 15, fq = lane >> 4, c = 16 * w + fr;
        const GAS u32x4* src = (const GAS u32x4*)(F.ws + WS_CHK + (size_t)(blk0 + n * bstride) * GDN_CHK);
        for (int idx = tid; idx < GDN_CHK / 16; idx += NTHR) ((LAS u32x4*)L)[idx] = src[idx];
        __syncthreads();
        const float ge = GEp[0];
        h8 sb[4];
#pragma unroll
        for (int ks = 0; ks < 4; ++ks)
#pragma unroll
            for (int e = 0; e < 4; ++e) { sb[ks][e] = (f16)S[2 * ks][e]; sb[ks][4 + e] = (f16)S[2 * ks + 1][e]; }
        f32x4 vn[4], o[4];
#pragma unroll
        for (int tt = 0; tt < 4; ++tt) { const h4 u = *(const LAS h4*)(UT + c * 72 + 16 * tt + 4 * fq);
            vn[tt] = (f32x4){(float)u[0], (float)u[1], (float)u[2], (float)u[3]}; o[tt] = (f32x4){0.f, 0.f, 0.f, 0.f};
#pragma unroll
            for (int ks = 0; ks < 4; ++ks) { const LAS f16* p = NW + (16 * tt + fr) * 136 + 32 * ks + 4 * fq; const LAS f16* q = QD + (16 * tt + fr) * 136 + 32 * ks + 4 * fq;
                vn[tt] = MFMA16(cat44(*(const LAS h4*)p, *(const LAS h4*)(p + 16)), sb[ks], vn[tt]);
                o[tt] = MFMA16(cat44(*(const LAS h4*)q, *(const LAS h4*)(q + 16)), sb[ks], o[tt]); } }
        h8 vb[2];
#pragma unroll
        for (int k2 = 0; k2 < 2; ++k2)
#pragma unroll
            for (int e = 0; e < 4; ++e) { vb[k2][e] = (f16)vn[2 * k2][e]; vb[k2][4 + e] = (f16)vn[2 * k2 + 1][e]; }
#pragma unroll
        for (int tt = 0; tt < 4; ++tt)
#pragma unroll
            for (int k2 = 0; k2 < 2; ++k2) { const LAS f16* p = ATT + (16 * tt + fr) * 72 + 32 * k2 + 4 * fq; o[tt] = MFMA16(cat44(*(const LAS h4*)p, *(const LAS h4*)(p + 16)), vb[k2], o[tt]); }
#pragma unroll
        for (int tt = 0; tt < 4; ++tt)
#pragma unroll
            for (int r = 0; r < 4; ++r) OT[(16 * tt + 4 * fq + r) * 136 + c] = (f16)o[tt][r];
#pragma unroll
        for (int dt = 0; dt < 8; ++dt) { S[dt] = S[dt] * ge;
#pragma unroll
            for (int k2 = 0; k2 < 2; ++k2) { const LAS f16* p = KET + (16 * dt + fr) * 72 + 32 * k2 + 4 * fq; S[dt] = MFMA16(cat44(*(const LAS h4*)p, *(const LAS h4*)(p + 16)), vb[k2], S[dt]); } }
        __syncthreads();
        {
            const int t = tid >> 3, c0 = (tid & 7) * 16;
            h8 ov[2]; float ss = 0.f;
#pragma unroll
            for (int i = 0; i < 2; ++i) { ov[i] = *(const LAS h8*)(OT + t * 136 + c0 + 8 * i);
#pragma unroll
                for (int e = 0; e < 8; ++e) { const float v = (float)ov[i][e]; ss += v * v; } }
            ss += __shfl_xor(ss, 1); ss += __shfl_xor(ss, 2); ss += __shfl_xor(ss, 4);
            const float rstd = 1.f / sqrtf(ss * (1.f / 128.f) + NORM_EPS);
            if (t < nvalid) { const size_t row = (size_t)row0 + n * 64 + t;
#pragma unroll
                for (int i = 0; i < 2; ++i) { const h8 zz = *(const GAS h8*)(Hb + row * GDN_LD + 3072 + h * 128 + c0 + 8 * i);
                    const f32x4 g0 = *(const f32x4*)(gnp + c0 + 8 * i), g1 = *(const f32x4*)(gnp + c0 + 8 * i + 4);
                    float ov_[8];
#pragma unroll
                    for (int e = 0; e < 8; ++e) ov_[e] = (float)ov[i][e] * rstd * (e < 4 ? g0[e] : g1[e - 4]) * siluf_((float)zz[e]);
                    u32x4 wv; wv.x = pkh(ov_[0], ov_[1]); wv.y = pkh(ov_[2], ov_[3]); wv.z = pkh(ov_[4], ov_[5]); wv.w = pkh(ov_[6], ov_[7]);
                    *(GAS u32x4*)(OG + row * DM + h * 128 + c0 + 8 * i) = wv; } }
        }
        __syncthreads();
    }
    {
        const int lane = F.lane, fr = lane & 15, fq = lane >> 4, c = 16 * F.wave + fr;
#pragma unroll
        for (int dt = 0; dt < 8; ++dt)
#pragma unroll
            for (int r = 0; r < 4; ++r) { const int d = 16 * dt + 4 * fq + r; Sout[(size_t)d * 128 + c] = S[dt][r]; }
    }
}
DI void gdn_pre_phase(Frame& F) {
    for (int it = F.bid; it < 3072; it += F.G) gdn_pre_item(F, it);
    const f16* Hb = (const f16*)(F.ws + WS_H);
    const int gt = F.bid * NTHR + F.tid, NT = F.G * NTHR;
    for (int idx = gt; idx < 8 * 3 * 3072; idx += NT) { const int ch = idx % 3072, i = (idx / 3072) % 3, b = idx / (3 * 3072); F.out[O_PCONV + idx] = (float)Hb[(size_t)(b * 2048 + 2045 + i) * GDN_LD + ch]; }
    for (int idx = gt; idx < 128 * 3 * 3072; idx += NT) { const int ch = idx % 3072, i = (idx / 3072) % 3, b = idx / (3 * 3072); F.out[O_SCONV + idx] = (float)Hb[(size_t)(MP + b * 8 + 5 + i) * GDN_LD + ch]; }
}
DI void gdn_scan_phase(Frame& F) {
    const float* S0all = F.a->in[I_SGDN]; float* pout = F.out + O_PGDN; float* sout = F.out + O_SGDN;
    if (F.bid < 64 && F.bid < F.G) { const int b = F.bid >> 3, h = F.bid & 7; gdn_scan_seq(F, h, b * 256 + h, 8, 32, b * 2048, 64, nullptr, pout + (size_t)(b * 8 + h) * 128 * 128); }
    const int first = (F.G > 128) ? 64 : 0, nw = F.G - first;
    if (F.bid >= first) for (int s = F.bid - first; s < 1024; s += nw) { const int b = s >> 3, h = s & 7;
        gdn_scan_seq(F, h, 2048 + s, 0, 1, MP + b * 8, 8, S0all + (size_t)s * 128 * 128, sout + (size_t)s * 128 * 128); }
}

constexpr int S5_HS_BYTES = 32 * 136 * 2;
DI float gelu_tanh(float x) { const float z = 0.7978845608028654f * (x + 0.044715f * x * x * x); const float e = __expf(2.f * z); return 0.5f * x * (1.f + (1.f - 2.f / (e + 1.f))); }

DI void s5_seq(Frame& F, int g, int row0, int Lsteps, const float* h0re, const float* h0im, float* ore, float* oim) {
    const Args& A = *F.a;
    const int lane = F.lane, l31 = lane & 31, hh = lane >> 5, fr = lane & 15, fq = lane >> 4;
    LAS f16* HS = (LAS f16*)(F.lds + F.wave * S5_HS_BYTES);
    const f16* Hb = (const f16*)(F.ws + WS_H); f16* Y = (f16*)(F.ws + WS_OG);
    const float dt = __expf(A.in[I_S5_LDT][g]), idt = 1.f / dt;
    float abr[2], abi[2], hre[2], him[2]; h8 bfr[4], cfr[4];
#pragma unroll
    for (int s = 0; s < 2; ++s) { const int p = l31 + 32 * s;
        const float lr = A.in[I_S5_LRE][g * 64 + p], li = A.in[I_S5_LIM][g * 64 + p];
        const float mag = expf(lr * dt); float sn, cs; sincosf(li * dt, &sn, &cs);
        abr[s] = mag * cs; abi[s] = mag * sn;
        const float den = lr * lr + li * li, nr = abr[s] - 1.f;
        const float cr = (nr * lr + abi[s] * li) / den * idt, ci = (abi[s] * lr - nr * li) / den * idt;
        const float* br = A.in[I_S5_BRE] + (size_t)(g * 64 + p) * 16 + 8 * hh; const float* bi = A.in[I_S5_BIM] + (size_t)(g * 64 + p) * 16 + 8 * hh;
#pragma unroll
        for (int e = 0; e < 8; ++e) { bfr[2 * s][e] = (f16)(cr * br[e] - ci * bi[e]); bfr[2 * s + 1][e] = (f16)(cr * bi[e] + ci * br[e]); }
        hre[s] = h0re ? h0re[g * 64 + p] : 0.f; him[s] = h0im ? h0im[g * 64 + p] : 0.f; }
#pragma unroll
    for (int ks = 0; ks < 4; ++ks)
#pragma unroll
        for (int e = 0; e < 8; ++e) { const int k = 32 * ks + 8 * fq + e, p = k >> 1;
            cfr[ks][e] = (k & 1) ? (f16)(-A.in[I_S5_CIM][(size_t)(g * 16 + fr) * 64 + p]) : (f16)(A.in[I_S5_CRE][(size_t)(g * 16 + fr) * 64 + p]); }
    const float dvec = A.in[I_S5_D][g * 16 + fr];
    for (int t0 = 0; t0 < Lsteps; t0 += 32) {
        h8 a;
        if (t0 + l31 < Lsteps) a = *(const GAS h8*)(Hb + (size_t)(row0 + t0 + l31) * S5_LD + g * 16 + 8 * hh);
        else {
#pragma unroll
            for (int e = 0; e < 8; ++e) a[e] = (f16)0.f; }
        f32x16 bu[4];
#pragma unroll
        for (int n = 0; n < 4; ++n) {
#pragma unroll
            for (int r = 0; r < 16; ++r) bu[n][r] = 0.f;
            bu[n] = MFMA32(a, bfr[n], bu[n]); }
        const int ngrp = (Lsteps - t0 >= 32) ? 8 : ((Lsteps - t0) >> 2);
#pragma unroll
        for (int gi = 0; gi < 8; ++gi) {
            if (gi < ngrp) {
                const bool own = (hh == (gi & 1));
#pragma unroll
                for (int s = 0; s < 2; ++s) { float re = hre[s], im = him[s];
#pragma unroll
                    for (int r = 0; r < 4; ++r) { const int reg = 4 * (gi >> 1) + r;
                        const float nre = abr[s] * re - abi[s] * im + bu[2 * s][reg] * dt, nim = abr[s] * im + abi[s] * re + bu[2 * s + 1][reg] * dt;
                        re = nre; im = nim;
                        bu[2 * s][reg] = own ? re : bu[2 * s][reg]; bu[2 * s + 1][reg] = own ? im : bu[2 * s + 1][reg]; }
                    const float xr = __shfl_xor(re, 32), xi = __shfl_xor(im, 32);
                    hre[s] = own ? re : xr; him[s] = own ? im : xi; }
            }
        }
#pragma unroll
        for (int s = 0; s < 2; ++s)
#pragma unroll
            for (int r = 0; r < 16; ++r) { const int t = (r & 3) + 8 * (r >> 2) + 4 * hh; *(LAS unsigned*)(HS + t * 136 + 2 * (l31 + 32 * s)) = pkh(bu[2 * s][r], bu[2 * s + 1][r]); }
        LDS_WAIT(); __builtin_amdgcn_wave_barrier();
        f32x4 y[2];
#pragma unroll
        for (int mt = 0; mt < 2; ++mt) { y[mt] = (f32x4){0.f, 0.f, 0.f, 0.f};
#pragma unroll
            for (int ks = 0; ks < 4; ++ks) { const h8 ha = *(const LAS h8*)(HS + (16 * mt + fr) * 136 + 32 * ks + 8 * fq); y[mt] = MFMA16(ha, cfr[ks], y[mt]); } }
        LDS_WAIT(); __builtin_amdgcn_wave_barrier();
#pragma unroll
        for (int mt = 0; mt < 2; ++mt)
#pragma unroll
            for (int r = 0; r < 4; ++r) { const int t = t0 + 16 * mt + 4 * fq + r;
                if (t < Lsteps) { const size_t row = (size_t)row0 + t; const float u = (float)Hb[row * S5_LD + g * 16 + fr];
                    Y[row * DM + g * 16 + fr] = (f16)gelu_tanh(y[mt][r] + dvec * u); } }
    }
    if (hh == 0) {
#pragma unroll
        for (int s = 0; s < 2; ++s) { ore[g * 64 + l31 + 32 * s] = hre[s]; oim[g * 64 + l31 + 32 * s] = him[s]; } }
}
DI void s5_scan_phase(Frame& F) {
    const Args& A = *F.a;
    if (F.wave < 2) {
        for (int sid = F.bid * 2 + F.wave; sid < 512; sid += F.G * 2) { const int b = sid >> 6, g = sid & 63;
            s5_seq(F, g, b * 2048, 2048, nullptr, nullptr, F.out + O_PS5R + (size_t)b * 4096, F.out + O_PS5I + (size_t)b * 4096); }
    } else {
        for (int sid = F.bid * 6 + (F.wave - 2); sid < 8192; sid += F.G * 6) { const int b = sid >> 6, g = sid & 63;
            s5_seq(F, g, MP + b * 8, 8, A.in[I_SS5R] + (size_t)b * 4096, A.in[I_SS5I] + (size_t)b * 4096, F.out + O_SS5R + (size_t)b * 4096, F.out + O_SS5I + (size_t)b * 4096); }
    }
}

#ifndef MK_PER_PHASE
#define MK_PER_PHASE 0
#endif
constexpr int N_PHASES = 21;
__global__ void __launch_bounds__(NTHR, 2) fwd_kernel(Args args) {
    extern __shared__ __attribute__((aligned(16))) unsigned char lds_raw[];
    Frame F;
    F.lds = (LAS unsigned char*)lds_raw;
    F.tid = threadIdx.x; F.lane = F.tid & 63; F.wave = __builtin_amdgcn_readfirstlane(F.tid >> 6);
    F.G = gridDim.x; F.bid = blockIdx.x; F.a = &args; F.ws = args.ws; F.out = args.out;
    volatile LAS unsigned* MISC = (volatile LAS unsigned*)(F.lds + LDSCTL_OFF);
    for (int u = F.tid; u < (LDS_BYTES - LDSCTL_OFF) / 4; u += NTHR) MISC[u] = 0u;
    __syncthreads();
    XcdBarrier bar; bar.bar = (unsigned*)(F.ws + WS_CTL) + CW_BAR; bar.x = 0; bar.st = nullptr;
    if (!MK_PER_PHASE) bar = xcd_barrier_post((unsigned*)(F.ws + WS_CTL) + CW_BAR, MISC + 8);
    const int lo = args.ph_lo, hi = args.ph_hi;
    LAS unsigned char* lds = F.lds;
    f16* X16 = (f16*)(F.ws + WS_X16); f16* Hbuf = (f16*)(F.ws + WS_H); f16* OGb = (f16*)(F.ws + WS_OG); float* Fb = (float*)(F.ws + WS_F); f16* YG = (f16*)(F.ws + WS_YG);
#define IN(k) (lo <= (k) && (k) < hi)
#define SEAM(k) do { if (!MK_PER_PHASE && IN((k) + 1)) xcd_barrier(bar); } while (0)
#define GEMM_F16(Aop, Wt, N, Out, ldo) do { pg8::Gemm g_{(Aop), (Wt), M, (N), DM}; pg8::StaticOrder S_; S_.init(M, (N), F.G, F.bid); pg8::EpiF16 E_{(Out), (ldo)}; \
        pg8::gemm_phase<pg8::EpiF16, pg8::StaticOrder, true, true>(lds, g_, S_, E_, F.tid); } while (0)
#define GEMM_F32(Aop, Wt, Out) do { pg8::Gemm g_{(Aop), (Wt), M, DM, DM}; pg8::StaticOrder S_; S_.init(M, DM, F.G, F.bid); pg8::EpiF32 E_{(Out), DM}; \
        pg8::gemm_phase<pg8::EpiF32, pg8::StaticOrder, true, true>(lds, g_, S_, E_, F.tid); } while (0)

#define PH_BEGIN() do { int t_ = threadIdx.x; asm volatile("" : "+v"(t_)); F.tid = t_; F.lane = t_ & 63; F.wave = __builtin_amdgcn_readfirstlane(t_ >> 6); } while (0)
#define GLA_LAYER(jl, p0, layer) do { \
        if (IN(p0))     { PH_BEGIN(); GEMM_F16(X16, (const f16*)(F.ws + WS_WGLAIN + (jl) * SZ_WGLAIN), GLA_LD, Hbuf, GLA_LD); SEAM(p0); } \
        if (IN(p0 + 1)) { PH_BEGIN(); gla_pre_phase(F, jl); SEAM(p0 + 1); } \
        if (IN(p0 + 2)) { PH_BEGIN(); gla_scan_phase(F, jl); SEAM(p0 + 2); } \
        if (IN(p0 + 3)) { PH_BEGIN(); GEMM_F32(OGb, (const f16*)(F.ws + WS_WGLAOUT + (jl) * SZ_W1K), Fb); SEAM(p0 + 3); } \
        if (IN(p0 + 4)) { PH_BEGIN(); ln_phase(F, layer, (layer) == 3); SEAM(p0 + 4); } } while (0)

    if (IN(0)) { PH_BEGIN(); p0_prologue(F); SEAM(0); }
    GLA_LAYER(0, 1, 0);
    if (IN(6))  { PH_BEGIN(); GEMM_F16(X16, (const f16*)(F.ws + WS_WGDNIN), GDN_LD, Hbuf, GDN_LD); SEAM(6); }
    if (IN(7))  { PH_BEGIN(); gdn_pre_phase(F); SEAM(7); }
    if (IN(8))  { PH_BEGIN(); gdn_scan_phase(F); SEAM(8); }
    if (IN(9))  { PH_BEGIN(); GEMM_F32(OGb, (const f16*)(F.ws + WS_WGDNOUT), Fb); SEAM(9); }
    if (IN(10)) { PH_BEGIN(); ln_phase(F, 1, false); SEAM(10); }
    if (IN(11)) { PH_BEGIN(); GEMM_F16(X16, (const f16*)(F.ws + WS_WS5IN), S5_LD, Hbuf, S5_LD); SEAM(11); }
    if (IN(12)) { PH_BEGIN(); s5_scan_phase(F); SEAM(12); }
    if (IN(13)) { PH_BEGIN(); pg8::Gemm g_{OGb, (const f16*)(F.ws + WS_WS5GLU), M, 2048, DM}; pg8::StaticOrder S_; S_.init(M, 2048, F.G, F.bid);
                  pg8::EpiGlu E_{YG, Hbuf + 1024, S5_LD, args.in[I_S5_BGLU]};
                  pg8::gemm_phase<pg8::EpiGlu, pg8::StaticOrder, true, true>(lds, g_, S_, E_, F.tid); SEAM(13); }
    if (IN(14)) { PH_BEGIN(); GEMM_F32(YG, (const f16*)(F.ws + WS_WS5OUT), Fb); SEAM(14); }
    if (IN(15)) { PH_BEGIN(); ln_phase(F, 2, false); SEAM(15); }
    GLA_LAYER(1, 16, 3);
#undef IN
#undef SEAM
}

extern "C" void kernel_launch(void* const* d_in, const int* in_sizes, int n_in, void* d_out, int out_size, void* d_ws, size_t ws_size, hipStream_t stream) {
    static int grid = 0;
    if (grid == 0) {
        if (n_in != 32 || (size_t)out_size != O_END || ws_size < WS_END) { fprintf(stderr, "kernel_launch: unexpected shapes (n_in %d, out %d, ws %zu); nothing launched\n", n_in, out_size, ws_size); grid = -1; return; }
        int dev = 0, cus = 0, per_cu = 0;
        if (hipGetDevice(&dev) != hipSuccess || hipDeviceGetAttribute(&cus, hipDeviceAttributeMultiprocessorCount, dev) != hipSuccess) { grid = -1; return; }
        if (hipFuncSetAttribute((const void*)fwd_kernel, hipFuncAttributeMaxDynamicSharedMemorySize, LDS_BYTES) != hipSuccess) { fprintf(stderr, "kernel_launch: hipFuncSetAttribute failed\n"); grid = -1; return; }
        if (hipOccupancyMaxActiveBlocksPerMultiprocessor(&per_cu, (const void*)fwd_kernel, NTHR, LDS_BYTES) != hipSuccess || per_cu < 1) { fprintf(stderr, "kernel_launch: occupancy query says %d blocks per CU\n", per_cu); per_cu = 1; }
        (void)hipGetLastError();
        grid = cus;
    }
    if (grid < 0) return;
    (void)hipMemsetAsync((char*)d_ws + WS_CTL, 0, CTL_ZERO_BYTES, stream);
    Args a{};
    for (int i = 0; i < 32; ++i) a.in[i] = (const float*)d_in[i];
    a.out = (float*)d_out; a.ws = (unsigned char*)d_ws;
#if MK_PER_PHASE
    for (int p = 0; p < N_PHASES; ++p) { a.ph_lo = p; a.ph_hi = p + 1; hipLaunchKernelGGL(fwd_kernel, dim3(grid), dim3(NTHR), LDS_BYTES, stream, a); }
#else
    a.ph_lo = 0; a.ph_hi = N_PHASES;
    hipLaunchKernelGGL(fwd_kernel, dim3(grid), dim3(NTHR), LDS_BYTES, stream, a);
#endif
}
```

```cpp
#include <hip/hip_runtime.h>
#include <cstdio>
#include <cstdint>

#define LAS __attribute__((address_space(3)))
#define GAS __attribute__((address_space(1)))
typedef _Float16 f16;
typedef _Float16 h8 __attribute__((ext_vector_type(8)));
typedef _Float16 h4 __attribute__((ext_vector_type(4)));
typedef _Float16 h2 __attribute__((ext_vector_type(2)));
typedef float f32x2 __attribute__((ext_vector_type(2)));
typedef float f32x4 __attribute__((ext_vector_type(4)));
typedef float f32x16 __attribute__((ext_vector_type(16)));
typedef unsigned u32x2 __attribute__((ext_vector_type(2)));
typedef unsigned u32x4 __attribute__((ext_vector_type(4)));
#define DI __device__ __forceinline__
#define MFMA16(a, b, c) __builtin_amdgcn_mfma_f32_16x16x32_f16((a), (b), (c), 0, 0, 0)
#define MFMA32(a, b, c) __builtin_amdgcn_mfma_f32_32x32x16_f16((a), (b), (c), 0, 0, 0)
#define LDS_WAIT() asm volatile("s_waitcnt lgkmcnt(0)" ::: "memory")
#define VM_WAIT() asm volatile("s_waitcnt vmcnt(0)" ::: "memory")

DI unsigned pkh(float lo, float hi) { h2 v; v.x = (f16)lo; v.y = (f16)hi; return __builtin_bit_cast(unsigned, v); }
DI h8 cat44(h4 a, h4 b) { return __builtin_shufflevector(a, b, 0, 1, 2, 3, 4, 5, 6, 7); }
DI float sigmoidf_(float x) { return 1.0f / (1.0f + __expf(-x)); }
DI float siluf_(float x) { return x / (1.0f + __expf(-x)); }

namespace pg8 {
constexpr int BM = 256, BK = 64, HALF = 128, HTB = HALF * BK * 2, STAGE_BYTES = 8 * HTB, NXCD = 8, WGM = 8;
__host__ __device__ __forceinline__ int lds_byte(int r, int c) { const int st = (r >> 4) * 2 + (c >> 5), rr = r & 15, cc = c & 31, ob = rr * 64 + cc * 2; return st * 1024 + (ob ^ (((ob >> 9) & 1) << 5)); }
__host__ __device__ __forceinline__ void stage_rc(int b, int& R, int& C) { const int st = b / 1024, sb = b % 1024, swz = sb ^ (((sb >> 9) & 1) << 5); R = (st >> 1) * 16 + swz / 64; C = (st & 1) * 32 + (swz % 64) / 2; }
__host__ __device__ __forceinline__ int perm32(int rho) { const int n = rho >> 4, i = rho & 15; return 8 * (i >> 2) + 4 * n + (i & 3); }

struct Unit { int pm, pn; };
struct Gemm { const f16* A; const f16* Bt; int M, N, K; };

struct StaticOrder {
    int nM, nN, nwg, G, c;
    __host__ __device__ void init(int M, int N, int G_, int c_) { nM = M / BM; nN = N / BM; nwg = nM * nN; G = G_; c = c_; }
    __host__ __device__ bool next(int i, Unit& u) const {
        const long L = (long)i * G + c; if (L >= nwg) return false;
        int wgid = (int)L; { const int q = nwg / NXCD, r = nwg % NXCD, xcd = wgid % NXCD, off = wgid / NXCD; wgid = (xcd < r ? xcd * (q + 1) : r * (q + 1) + (xcd - r) * q) + off; }
        const int nig = WGM * nN, gid = wgid / nig, fm = gid * WGM, gsz = (nM - fm) < WGM ? (nM - fm) : WGM;
        u.pm = fm + ((wgid % nig) % gsz); u.pn = (wgid % nig) / gsz; return true;
    }
    __device__ __forceinline__ void a_ready(const Unit&) const {}
    __device__ __forceinline__ void done(const Unit&) const {}
};

struct EpiF16 {
    static constexpr bool PERM = true, AFTER_DRAIN = false;
    f16* O; int ldc;
    __device__ __forceinline__ void operator()(const f32x4 (&acc)[2][2][4][2], const Unit& u, int wr, int wc, int fr, int fq) const {
        const int row0 = u.pm * BM + wr * 64 + fr, col0 = u.pn * BM + wc * 32 + 8 * fq;
#pragma unroll
        for (int ai = 0; ai < 2; ++ai)
#pragma unroll
            for (int m = 0; m < 4; ++m) { f16* rowp = O + (size_t)(row0 + ai * HALF + m * 16) * ldc + col0;
#pragma unroll
                for (int bj = 0; bj < 2; ++bj) { const f32x4 v0 = acc[ai][bj][m][0], v1 = acc[ai][bj][m][1];
                    u32x4 w; w.x = pkh(v0[0], v0[1]); w.y = pkh(v0[2], v0[3]); w.z = pkh(v1[0], v1[1]); w.w = pkh(v1[2], v1[3]);
                    *(u32x4*)(rowp + bj * HALF) = w; } }
    }
};
struct EpiF32 {
    static constexpr bool PERM = false, AFTER_DRAIN = false;
    float* C; int ldc;
    __device__ __forceinline__ void operator()(const f32x4 (&acc)[2][2][4][2], const Unit& u, int wr, int wc, int fr, int fq) const {
        const int row0 = u.pm * BM + wr * 64 + fr, col0 = u.pn * BM + wc * 32 + 4 * fq;
#pragma unroll
        for (int ai = 0; ai < 2; ++ai)
#pragma unroll
            for (int m = 0; m < 4; ++m) { float* rowp = C + (size_t)(row0 + ai * HALF + m * 16) * ldc + col0;
#pragma unroll
                for (int bj = 0; bj < 2; ++bj)
#pragma unroll
                    for (int n = 0; n < 2; ++n) *(f32x4*)(rowp + bj * HALF + n * 16) = acc[ai][bj][m][n]; }
    }
};
struct EpiGlu {
    static constexpr bool PERM = true, AFTER_DRAIN = false;
    f16* O; const f16* Z; int ldz; const float* bias;
    __device__ __forceinline__ void operator()(const f32x4 (&acc)[2][2][4][2], const Unit& u, int wr, int wc, int fr, int fq) const {
        const int row0 = u.pm * BM + wr * 64 + fr, col0 = u.pn * HALF + wc * 32 + 8 * fq;
        const f32x4 b10 = *(const f32x4*)(bias + col0), b11 = *(const f32x4*)(bias + col0 + 4), b20 = *(const f32x4*)(bias + 1024 + col0), b21 = *(const f32x4*)(bias + 1024 + col0 + 4);
#pragma unroll
        for (int ai = 0; ai < 2; ++ai)
#pragma unroll
            for (int m = 0; m < 4; ++m) { const int row = row0 + ai * HALF + m * 16;
                const h8 z = *(const h8*)(Z + (size_t)row * ldz + col0);
                const f32x4 y10 = acc[ai][0][m][0] + b10, y11 = acc[ai][0][m][1] + b11, y20 = acc[ai][1][m][0] + b20, y21 = acc[ai][1][m][1] + b21;
                float o[8];
#pragma unroll
                for (int i = 0; i < 4; ++i) { o[i] = y10[i] * sigmoidf_(y20[i]) * siluf_((float)z[i]); o[4 + i] = y11[i] * sigmoidf_(y21[i]) * siluf_((float)z[4 + i]); }
                u32x4 w; w.x = pkh(o[0], o[1]); w.y = pkh(o[2], o[3]); w.z = pkh(o[4], o[5]); w.w = pkh(o[6], o[7]);
                *(u32x4*)(O + (size_t)row * 1024 + col0) = w; }
    }
};

template <class Epi, class Sched, bool ALIGN_EPI = false, bool SP2 = false>
__device__ __forceinline__ void gemm_phase(LAS unsigned char* lds, const Gemm g, const Sched& S, const Epi& E, const int tid) {
    const int wid = __builtin_amdgcn_readfirstlane(tid >> 6), lane = tid & 63, wr = wid >> 2, wc = wid & 3, fr = lane & 15, fq = lane >> 4;
    const int K = g.K, nt = K / BK;
    unsigned voffA[2], voffB[2];
#pragma unroll
    for (int i = 0; i < 2; ++i) { int R, C; stage_rc(tid * 16 + i * 8192, R, C); const int Rb = Epi::PERM ? ((R & ~31) + perm32(R & 31)) : R;
        voffA[i] = (unsigned)(R * K + C) * 2u; voffB[i] = (unsigned)(Rb * K + C) * 2u; }
    const size_t kstep = (size_t)(BK * 2);
    const size_t hstep = (size_t)HALF * K * 2;
    const size_t tstep = 2 * hstep;
    const unsigned ldsw = (unsigned)wid * 1024u;
    const int aoff = lds_byte(wr * 64 + fr, fq * 8), boff = lds_byte(wc * 32 + fr, fq * 8);
#define PG8_SA(b, h) (((b) * 2 + (h)) * HTB)
#define PG8_SB(b, h) ((4 + (b) * 2 + (h)) * HTB)
#define PG8_STAGE(bufoff, gbase, voff) do { _Pragma("unroll") for (int _i = 0; _i < 2; ++_i) \
        __builtin_amdgcn_global_load_lds((const unsigned*)((const char*)(gbase) + (voff)[_i]), (LAS unsigned*)(lds + (bufoff) + ldsw + _i * 8192), 16, 0, 0); } while (0)
#define PG8_LDA(dst, b, h) do { _Pragma("unroll") for (int m = 0; m < 4; ++m) _Pragma("unroll") for (int k = 0; k < 2; ++k) dst[m][k] = *(const LAS h8*)(lds + PG8_SA(b, h) + aoff + m * 2048 + k * 1024); } while (0)
#define PG8_LDB(dst, b, h) do { _Pragma("unroll") for (int n = 0; n < 2; ++n) _Pragma("unroll") for (int k = 0; k < 2; ++k) dst[n][k] = *(const LAS h8*)(lds + PG8_SB(b, h) + boff + n * 2048 + k * 1024); } while (0)
#define PG8_MMA(ai, bj, At, Bt) do { __builtin_amdgcn_s_setprio(1); _Pragma("unroll") for (int m = 0; m < 4; ++m) _Pragma("unroll") for (int n = 0; n < 2; ++n) _Pragma("unroll") for (int k = 0; k < 2; ++k) \
        acc[ai][bj][m][n] = __builtin_amdgcn_mfma_f32_16x16x32_f16(Bt[n][k], At[m][k], acc[ai][bj][m][n], 0, 0, 0); __builtin_amdgcn_s_setprio(0); } while (0)
#define PG8_WAIT_V(n) asm volatile("s_waitcnt vmcnt(" #n ")" ::: "memory")
#define PG8_WAIT_L(n) asm volatile("s_waitcnt lgkmcnt(" #n ")" ::: "memory")
#define PG8_BAR __builtin_amdgcn_s_barrier()
#define PG8_SCHED __builtin_amdgcn_sched_barrier(0)
    Unit cur, nxt; int ui = 0;
    if (!S.next(0, cur)) return;
    f32x4 acc[2][2][4][2];
#pragma unroll
    for (int a = 0; a < 2; ++a)
#pragma unroll
        for (int b = 0; b < 2; ++b)
#pragma unroll
            for (int m = 0; m < 4; ++m)
#pragma unroll
                for (int n = 0; n < 2; ++n) acc[a][b][m][n] = (f32x4){0.f, 0.f, 0.f, 0.f};
    h8 At[4][2], B0[2][2], B1[2][2];
    const char* cA = (const char*)g.A + (size_t)cur.pm * tstep; const char* cB = (const char*)g.Bt + (size_t)cur.pn * tstep;
    S.a_ready(cur);
    if constexpr (SP2) {
        PG8_STAGE(PG8_SB(0, 0), cB, voffB); PG8_STAGE(PG8_SB(0, 1), cB + hstep, voffB); PG8_STAGE(PG8_SA(0, 0), cA, voffA); PG8_STAGE(PG8_SA(0, 1), cA + hstep, voffA);
        if (wr == 1) PG8_BAR;
        PG8_WAIT_V(2); PG8_BAR;
        PG8_STAGE(PG8_SB(1, 0), cB + kstep, voffB); PG8_STAGE(PG8_SA(1, 0), cA + kstep, voffA); PG8_STAGE(PG8_SB(1, 1), cB + hstep + kstep, voffB);
        PG8_WAIT_V(6); PG8_BAR;
    } else {
        PG8_STAGE(PG8_SB(0, 0), cB, voffB); PG8_STAGE(PG8_SA(0, 0), cA, voffA); PG8_STAGE(PG8_SB(0, 1), cB + hstep, voffB); PG8_STAGE(PG8_SA(0, 1), cA + hstep, voffA);
        if (wr == 1) PG8_BAR;
        PG8_WAIT_V(4); PG8_BAR;
        PG8_STAGE(PG8_SB(1, 0), cB + kstep, voffB); PG8_STAGE(PG8_SA(1, 0), cA + kstep, voffA); PG8_STAGE(PG8_SB(1, 1), cB + hstep + kstep, voffB);
        PG8_WAIT_V(6); PG8_BAR;
    }
    for (;;) {
        const bool has_next = S.next(ui + 1, nxt);
        const char* nA = has_next ? (const char*)g.A + (size_t)nxt.pm * tstep : cA; const char* nB = has_next ? (const char*)g.Bt + (size_t)nxt.pn * tstep : cB;
        for (int t = 0; t < nt; t += 2) {
            const bool last = (t == nt - 2);
            const char* a1 = cA + (size_t)(t + 1) * kstep;
            const char* a2 = last ? nA : cA + (size_t)(t + 2) * kstep; const char* b2 = last ? nB : cB + (size_t)(t + 2) * kstep;
            const char* a3 = a2 + kstep; const char* b3 = b2 + kstep;
            if (last && has_next) S.a_ready(nxt);
            if constexpr (SP2) {
            PG8_LDB(B0, 0, 0); PG8_LDB(B1, 0, 1); PG8_SCHED; PG8_LDA(At, 0, 0); PG8_STAGE(PG8_SA(1, 1), a1 + hstep, voffA);
            PG8_WAIT_V(8); PG8_WAIT_L(0); PG8_BAR; PG8_MMA(0, 0, At, B0); PG8_MMA(0, 1, At, B1); PG8_BAR; PG8_SCHED;
            PG8_LDA(At, 0, 1); PG8_STAGE(PG8_SB(0, 0), b2, voffB); PG8_STAGE(PG8_SB(0, 1), b2 + hstep, voffB); PG8_STAGE(PG8_SA(0, 0), a2, voffA);
            PG8_WAIT_V(8); PG8_WAIT_L(0); PG8_BAR; PG8_MMA(1, 0, At, B0); PG8_MMA(1, 1, At, B1); PG8_BAR; PG8_SCHED;
            PG8_LDB(B0, 1, 0); PG8_LDB(B1, 1, 1); PG8_SCHED; PG8_LDA(At, 1, 0); PG8_STAGE(PG8_SA(0, 1), a2 + hstep, voffA);
            PG8_WAIT_V(8); PG8_WAIT_L(0); PG8_BAR; PG8_MMA(0, 0, At, B0); PG8_MMA(0, 1, At, B1); PG8_BAR; PG8_SCHED;
            PG8_LDA(At, 1, 1); PG8_STAGE(PG8_SB(1, 0), b3, voffB); PG8_STAGE(PG8_SB(1, 1), b3 + hstep, voffB); PG8_STAGE(PG8_SA(1, 0), a3, voffA);
            PG8_WAIT_V(8); PG8_WAIT_L(0); PG8_BAR; PG8_MMA(1, 0, At, B0); PG8_MMA(1, 1, At, B1); PG8_BAR; PG8_SCHED;
            } else {
            PG8_LDB(B0, 0, 0); PG8_SCHED; PG8_LDA(At, 0, 0); PG8_STAGE(PG8_SA(1, 1), a1 + hstep, voffA);
            PG8_WAIT_L(8); PG8_BAR; PG8_WAIT_L(0); PG8_MMA(0, 0, At, B0); PG8_BAR; PG8_SCHED;
            PG8_LDB(B1, 0, 1); PG8_STAGE(PG8_SB(0, 0), b2, voffB);
            PG8_BAR; PG8_WAIT_L(0); PG8_MMA(0, 1, At, B1); PG8_BAR;
            PG8_LDA(At, 0, 1); PG8_STAGE(PG8_SA(0, 0), a2, voffA);
            PG8_BAR; PG8_WAIT_L(0); PG8_MMA(1, 0, At, B0); PG8_BAR; PG8_SCHED;
            PG8_STAGE(PG8_SB(0, 1), b2 + hstep, voffB);
            PG8_WAIT_V(6); PG8_BAR; PG8_MMA(1, 1, At, B1); PG8_BAR;
            PG8_LDB(B0, 1, 0); PG8_SCHED; PG8_LDA(At, 1, 0); PG8_STAGE(PG8_SA(0, 1), a2 + hstep, voffA);
            PG8_WAIT_L(8); PG8_BAR; PG8_WAIT_L(0); PG8_MMA(0, 0, At, B0); PG8_BAR; PG8_SCHED;
            PG8_LDB(B1, 1, 1); PG8_STAGE(PG8_SB(1, 0), b3, voffB);
            PG8_BAR; PG8_WAIT_L(0); PG8_MMA(0, 1, At, B1); PG8_BAR;
            PG8_LDA(At, 1, 1); PG8_STAGE(PG8_SA(1, 0), a3, voffA);
            PG8_BAR; PG8_WAIT_L(0); PG8_MMA(1, 0, At, B0); PG8_BAR; PG8_SCHED;
            PG8_STAGE(PG8_SB(1, 1), b3 + hstep, voffB);
            PG8_WAIT_V(6); PG8_BAR; PG8_MMA(1, 1, At, B1); PG8_BAR;
            }
        }
        if constexpr (ALIGN_EPI) { if (wr == 0) PG8_BAR; }
        if constexpr (!Epi::AFTER_DRAIN) { E(acc, cur, wr, wc, fr, fq); S.done(cur); }
        if (!has_next) break;
#pragma unroll
        for (int a = 0; a < 2; ++a)
#pragma unroll
            for (int b = 0; b < 2; ++b)
#pragma unroll
                for (int m = 0; m < 4; ++m)
#pragma unroll
                    for (int n = 0; n < 2; ++n) acc[a][b][m][n] = (f32x4){0.f, 0.f, 0.f, 0.f};
        cur = nxt; cA = nA; cB = nB; ++ui;
        if constexpr (ALIGN_EPI) { if (wr == 1) PG8_BAR; }
    }
    PG8_WAIT_V(0);
    if constexpr (!ALIGN_EPI) { if (wr == 0) PG8_BAR; }
    PG8_BAR;
#undef PG8_SA
#undef PG8_SB
#undef PG8_STAGE
#undef PG8_LDA
#undef PG8_LDB
#undef PG8_MMA
#undef PG8_WAIT_V
#undef PG8_WAIT_L
#undef PG8_BAR
#undef PG8_SCHED
}
}

constexpr int NWAVES = 8, NTHR = 512;
constexpr int DM = 1024;
constexpr int MP = 8 * 2048, MS = 128 * 8, M = MP + MS;
constexpr int GLA_LD = 3328, GDN_LD = 4352, S5_LD = 2048;
constexpr int GLA_IN = 3088, GDN_IN = 4112;
constexpr float ALPHA_RES = 1.681792830507429f;
constexpr float LN_EPS = 1e-5f, NORM_EPS = 1e-6f;

constexpr size_t O_YP = 0, O_YS = O_YP + (size_t)MP * DM, O_PGLA = O_YS + (size_t)MS * DM, O_PGDN = O_PGLA + 2ull * 8 * 4 * 128 * 256, O_PCONV = O_PGDN + 8ull * 8 * 128 * 128,
                 O_PS5R = O_PCONV + 8ull * 3 * 3072, O_PS5I = O_PS5R + 8ull * 64 * 64, O_SGLA = O_PS5I + 8ull * 64 * 64, O_SGDN = O_SGLA + 2ull * 128 * 4 * 128 * 256,
                 O_SCONV = O_SGDN + 128ull * 8 * 128 * 128, O_SS5R = O_SCONV + 128ull * 3 * 3072, O_SS5I = O_SS5R + 128ull * 64 * 64, O_END = O_SS5I + 128ull * 64 * 64;

constexpr size_t MiB = 1u << 20;
constexpr size_t WS_CTL = 0, CTL_ZERO_BYTES = 64 * 1024;
constexpr size_t SZ_WGLAIN = (size_t)GLA_LD * 1024 * 2, SZ_W1K = 1024ull * 1024 * 2, SZ_WGDNIN = (size_t)GDN_LD * 1024 * 2, SZ_W2K = 2048ull * 1024 * 2;
constexpr size_t WS_WGLAIN = 1 * MiB, WS_WGLAOUT = WS_WGLAIN + 2 * SZ_WGLAIN, WS_WGDNIN = WS_WGLAOUT + 2 * SZ_W1K, WS_WGDNOUT = WS_WGDNIN + SZ_WGDNIN,
                 WS_WS5IN = WS_WGDNOUT + SZ_W1K, WS_WS5GLU = WS_WS5IN + SZ_W2K, WS_WS5OUT = WS_WS5GLU + SZ_W2K, WS_WEND = WS_WS5OUT + SZ_W1K;
constexpr size_t WS_X16 = 41 * MiB;
constexpr size_t WS_H = WS_X16 + 34 * MiB;
constexpr size_t WS_OG = WS_H + 145 * MiB;
constexpr size_t WS_CHK = WS_OG + 34 * MiB;
constexpr size_t WS_F = WS_CHK, WS_YG = WS_CHK + 128 * MiB;
constexpr size_t WS_END = WS_CHK + 238 * MiB;
static_assert(WS_WEND <= WS_X16 && WS_END <= 512 * MiB, "d_ws map");
static_assert((size_t)M * 1024 * 2 <= 34 * MiB && (size_t)M * GDN_LD * 2 <= 145 * MiB && (size_t)M * 1024 * 4 <= 128 * MiB, "d_ws sizes");
constexpr int CW_BAR = 1024;

constexpr int GA_ATT = 0, GA_QD = 9216, GA_KET = GA_QD + 17408, GA_EBL = GA_KET + 18432, GA_VT = GA_EBL + 512, GLA_CHK = GA_VT + 36864;
constexpr int GA_STAGE = 46080;
constexpr int GD_ATT = 0, GD_QD = 9216, GD_NW = GD_QD + 17408, GD_KET = GD_NW + 17408, GD_GE = GD_KET + 18432, GD_UT = GD_GE + 64, GDN_CHK = GD_UT + 18432;
constexpr int GD_STAGE = 63488;
static_assert(GLA_CHK % 16 == 0 && GDN_CHK % 16 == 0, "chunk blocks are copied in 16-byte pieces");
static_assert((size_t)1536 * GLA_CHK <= 238 * MiB && (size_t)3072 * GDN_CHK <= 238 * MiB, "chunk area");

constexpr int LDS_BYTES = 163840;
constexpr int LDSCTL_OFF = LDS_BYTES - 256;

#define XB_TMO      128
#define XB_XCNT(j)  (256  + 64 * (j))
#define XB_XSUB(j)  (1280 + 64 * (j))
#define XB_XGEN(j)  (2304 + 64 * (j))
#define XB_TOP      3328
#define XB_TOPGEN   3392
#define XCD_BAR_WORDS 3456
#define XB_SPIN_CAP (1u << 18)
static_assert((CW_BAR + XCD_BAR_WORDS) * 4 <= (int)CTL_ZERO_BYTES, "barrier words inside the memset region");
__device__ __forceinline__ unsigned xb_ld(unsigned* p)              { return __hip_atomic_load(p, __ATOMIC_RELAXED, __HIP_MEMORY_SCOPE_AGENT); }
__device__ __forceinline__ unsigned xb_add(unsigned* p, unsigned v) { return __hip_atomic_fetch_add(p, v, __ATOMIC_RELAXED, __HIP_MEMORY_SCOPE_AGENT); }
__device__ __forceinline__ unsigned xb_xcc_id() { return (unsigned)__builtin_amdgcn_s_getreg((3 << 11) | 20) & 0xFu; }
#define XB_SPIN(cond, bar) do { unsigned _sp = 0; while (cond) { __builtin_amdgcn_s_sleep(1); \
    if ((++_sp & 255u) == 0u) { if (xb_ld(&(bar)[XB_TMO])) break; if (_sp > XB_SPIN_CAP) { atomicAdd(&(bar)[XB_TMO], 1u); break; } } } } while (0)
struct XcdBarrier { unsigned* bar; unsigned x; volatile LAS unsigned* st; };
__device__ __forceinline__ XcdBarrier xcd_barrier_post(unsigned* bar, volatile LAS unsigned* st) {
    XcdBarrier b; b.bar = bar; b.x = xb_xcc_id(); b.st = st;
    if (threadIdx.x == 0) (void)xb_add(&bar[XB_XCNT(b.x)], 1u);
    return b;
}
__device__ __forceinline__ void xcd_barrier_complete(unsigned* bar, unsigned x, unsigned& nloc, unsigned& nx) {
    const unsigned G = gridDim.x * gridDim.y * gridDim.z;
    unsigned sum, cnt, mine, sp = 0u;
    for (;;) {
        sum = 0u; cnt = 0u; mine = 0u;
#pragma unroll
        for (unsigned j = 0; j < 16; ++j) { const unsigned c = xb_ld(&bar[XB_XCNT(j)]); sum += c; cnt += (c > 0u) ? 1u : 0u; mine = (j == x) ? c : mine; }
        if (sum == G) break;
        __builtin_amdgcn_s_sleep(1);
        if ((++sp & 255u) == 0u) { if (xb_ld(&bar[XB_TMO])) break; if (sp > XB_SPIN_CAP) { atomicAdd(&bar[XB_TMO], 1u); break; } }
    }
    nloc = mine > 0u ? mine : 1u; nx = cnt > 0u ? cnt : 1u;
}
__device__ __forceinline__ void xcd_barrier(const XcdBarrier& b) {
    asm volatile("s_waitcnt vmcnt(0)" ::: "memory");
    __syncthreads();
    if (threadIdx.x == 0) {
        unsigned* bar = b.bar;
        __builtin_amdgcn_s_waitcnt(0);
        unsigned nloc = b.st[0], nx = b.st[1];
        if (nloc == 0u) { xcd_barrier_complete(bar, b.x, nloc, nx); b.st[0] = nloc; b.st[1] = nx; }
        const unsigned old = xb_add(&bar[XB_XSUB(b.x)], 1u);
        const unsigned gen = old / nloc;
        if (old + 1u == (gen + 1u) * nloc) {
            __builtin_amdgcn_fence(__ATOMIC_RELEASE, "agent");
            asm volatile("s_waitcnt vmcnt(0)" ::: "memory");
            const unsigned og = xb_add(&bar[XB_TOP], 1u);
            const unsigned tg = og / nx;
            if (og + 1u == (tg + 1u) * nx) xb_add(&bar[XB_TOPGEN], 1u);
            else XB_SPIN(xb_ld(&bar[XB_TOPGEN]) == tg, bar);
            __builtin_amdgcn_fence(__ATOMIC_ACQUIRE, "agent");
            xb_add(&bar[XB_XGEN(b.x)], 1u);
            asm volatile("s_waitcnt vmcnt(0)" ::: "memory");
        } else {
            XB_SPIN(xb_ld(&bar[XB_XGEN(b.x)]) == gen, bar);
            __builtin_amdgcn_fence(__ATOMIC_ACQUIRE, "agent");
            asm volatile("s_waitcnt vmcnt(0)" ::: "memory");
        }
    }
    __syncthreads();
}

struct Args { const float* in[32]; float* out; unsigned char* ws; int ph_lo, ph_hi; };
enum { I_XP = 0, I_XS, I_SGLA, I_SGDN, I_SCONV, I_SS5R, I_SS5I, I_LNG, I_LNB, I_GLA_WIN, I_GLA_WA2, I_GLA_BA, I_GLA_NG, I_GLA_WOUT,
       I_GDN_WIN, I_GDN_WCONV, I_GDN_ALOG, I_GDN_DTB, I_GDN_NG, I_GDN_WOUT, I_S5_WIN, I_S5_LRE, I_S5_LIM, I_S5_LDT, I_S5_BRE, I_S5_BIM, I_S5_CRE, I_S5_CIM,
       I_S5_D, I_S5_WGLU, I_S5_BGLU, I_S5_WOUT };
struct Frame {
    LAS unsigned char* lds;
    int tid, lane, wave, G, bid;
    const Args* a;
    unsigned char* ws; float* out;
};
DI float wave_sum(float v) {
#pragma unroll
    for (int o = 1; o < 64; o <<= 1) v += __shfl_xor(v, o);
    return v;
}

DI void p0_transpose_item(const float* W, int N, f16* WT, LAS float* scr, int item, int nblk, int lane, int glu) {
    const int kb = item / nblk, nb = item % nblk, k0 = 64 * kb, n0 = 32 * nb;
    const int nn = n0 + (lane & 31);
#pragma unroll 8
    for (int i = 0; i < 32; ++i) { const int kk = 2 * i + (lane >> 5); scr[kk * 33 + (lane & 31)] = (nn < N) ? W[(size_t)(k0 + kk) * N + nn] : 0.f; }
    LDS_WAIT(); asm volatile("" ::: "memory");
    const int c = lane & 7;
#pragma unroll
    for (int j = 0; j < 4; ++j) { const int n = (lane >> 3) + 8 * j; const LAS float* s = scr + (8 * c) * 33 + n;
        u32x4 o; o.x = pkh(s[0 * 33], s[1 * 33]); o.y = pkh(s[2 * 33], s[3 * 33]); o.z = pkh(s[4 * 33], s[5 * 33]); o.w = pkh(s[6 * 33], s[7 * 33]);
        int row = n0 + n;
        if (glu) { const int jj = row & 1023; row = 256 * (jj >> 7) + (row >= 1024 ? 128 : 0) + (jj & 127); }
        *(GAS u32x4*)(WT + (size_t)row * 1024 + k0 + 8 * c) = o; }
    LDS_WAIT(); asm volatile("" ::: "memory");
}
DI void p0_prologue(Frame& F) {
    LAS float* scr = (LAS float*)(F.lds + F.wave * 16384);
    const int gw = F.bid * NWAVES + F.wave, NGW = F.G * NWAVES;
    const Args& A = *F.a;
    constexpr int NB_GLA = GLA_LD / 32, NB_GDN = GDN_LD / 32;
    constexpr int I0 = 16 * NB_GLA, I1 = 16 * 32, I2 = 16 * NB_GDN, I3 = 16 * 64;
    constexpr int NITEMS = 2 * I0 + 2 * I1 + I2 + I1 + I3 + I3 + I1;
    for (int it = gw; it < NITEMS; it += NGW) {
        int r = it;
        if (r < 2 * I0) { const int j = r / I0; p0_transpose_item(A.in[I_GLA_WIN] + (size_t)j * 1024 * GLA_IN, GLA_IN, (f16*)(F.ws + WS_WGLAIN + j * SZ_WGLAIN), scr, r % I0, NB_GLA, F.lane, 0); continue; } r -= 2 * I0;
        if (r < 2 * I1) { const int j = r / I1; p0_transpose_item(A.in[I_GLA_WOUT] + (size_t)j * 1024 * 1024, 1024, (f16*)(F.ws + WS_WGLAOUT + j * SZ_W1K), scr, r % I1, 32, F.lane, 0); continue; } r -= 2 * I1;
        if (r < I2) { p0_transpose_item(A.in[I_GDN_WIN], GDN_IN, (f16*)(F.ws + WS_WGDNIN), scr, r, NB_GDN, F.lane, 0); continue; } r -= I2;
        if (r < I1) { p0_transpose_item(A.in[I_GDN_WOUT], 1024, (f16*)(F.ws + WS_WGDNOUT), scr, r, 32, F.lane, 0); continue; } r -= I1;
        if (r < I3) { p0_transpose_item(A.in[I_S5_WIN], 2048, (f16*)(F.ws + WS_WS5IN), scr, r, 64, F.lane, 0); continue; } r -= I3;
        if (r < I3) { p0_transpose_item(A.in[I_S5_WGLU], 2048, (f16*)(F.ws + WS_WS5GLU), scr, r, 64, F.lane, 1); continue; } r -= I3;
        p0_transpose_item(A.in[I_S5_WOUT], 1024, (f16*)(F.ws + WS_WS5OUT), scr, r, 32, F.lane, 0);
    }
    f16* X16 = (f16*)(F.ws + WS_X16);
    for (int m = gw; m < M; m += NGW) {
        const float* xr = (m < MP) ? A.in[I_XP] + (size_t)m * DM : A.in[I_XS] + (size_t)(m - MP) * DM;
        const GAS f32x4* x4 = (const GAS f32x4*)xr + F.lane;
        GAS u32x2* o8 = (GAS u32x2*)(X16 + (size_t)m * DM) + F.lane;
#pragma unroll
        for (int j = 0; j < 4; ++j) { const f32x4 v = x4[64 * j]; u32x2 o; o.x = pkh(v.x, v.y); o.y = pkh(v.z, v.w); o8[64 * j] = o; }
    }
}

DI void ln_phase(Frame& F, int layer, bool final_out) {
    const int gw = F.bid * NWAVES + F.wave, NGW = F.G * NWAVES;
    f16* X16 = (f16*)(F.ws + WS_X16); const float* Fb = (const float*)(F.ws + WS_F);
    const float* g = F.a->in[I_LNG] + layer * DM; const float* bb = F.a->in[I_LNB] + layer * DM;
    f32x4 gv[4], bv[4];
#pragma unroll
    for (int j = 0; j < 4; ++j) { gv[j] = *(const f32x4*)(g + 4 * F.lane + 256 * j); bv[j] = *(const f32x4*)(bb + 4 * F.lane + 256 * j); }
    for (int m = gw; m < M; m += NGW) {
        f32x4 v[4]; float s = 0.f;
#pragma unroll
        for (int j = 0; j < 4; ++j) { const f32x4 f = *(const GAS f32x4*)(Fb + (size_t)m * DM + 4 * F.lane + 256 * j); const h4 x = *(const GAS h4*)(X16 + (size_t)m * DM + 4 * F.lane + 256 * j);
            v[j].x = ALPHA_RES * (float)x.x + f.x; v[j].y = ALPHA_RES * (float)x.y + f.y; v[j].z = ALPHA_RES * (float)x.z + f.z; v[j].w = ALPHA_RES * (float)x.w + f.w;
            s += (v[j].x + v[j].y) + (v[j].z + v[j].w); }
        const float mean = wave_sum(s) * (1.f / DM); float s2 = 0.f;
#pragma unroll
        for (int j = 0; j < 4; ++j) { v[j] = v[j] - mean; s2 += (v[j].x * v[j].x + v[j].y * v[j].y) + (v[j].z * v[j].z + v[j].w * v[j].w); }
        const float rstd = 1.f / sqrtf(wave_sum(s2) * (1.f / DM) + LN_EPS);
#pragma unroll
        for (int j = 0; j < 4; ++j) { const f32x4 o = v[j] * rstd * gv[j] + bv[j];
            if (final_out) *(GAS f32x4*)(F.out + (size_t)m * DM + 4 * F.lane + 256 * j) = o;
            else { u32x2 w; w.x = pkh(o.x, o.y); w.y = pkh(o.z, o.w); *(GAS u32x2*)(X16 + (size_t)m * DM + 4 * F.lane + 256 * j) = w; } }
    }
}

DI void gla_pre_item(Frame& F, int j, int item) {
    LAS unsigned char* L = F.lds;
    LAS f16* ATT = (LAS f16*)(L + GA_ATT); LAS f16* QD = (LAS f16*)(L + GA_QD); LAS f16* KET = (LAS f16*)(L + GA_KET); LAS f16* VT = (LAS f16*)(L + GA_VT); LAS float* EBL = (LAS float*)(L + GA_EBL);
    LAS f16* KI = (LAS f16*)(L + GLA_CHK); LAS float* LR = (LAS float*)(L + GLA_CHK + 17408); LAS float* WA2 = LR + 1024; LAS float* PSUM = WA2 + 2048; LAS float* BC = PSUM + 512;
    int row0, nvalid, h;
    if (item < 1024) { const int b = item >> 7, n = (item >> 2) & 31; h = item & 3; row0 = b * 2048 + n * 64; nvalid = 64; }
    else { const int s = item - 1024; h = s & 3; row0 = MP + (s >> 2) * 8; nvalid = 8; }
    const f16* Hb = (const f16*)(F.ws + WS_H) + (size_t)row0 * GLA_LD;
    const float* wa2 = F.a->in[I_GLA_WA2] + (size_t)j * 16 * 512; const float* ba = F.a->in[I_GLA_BA] + j * 512;
    int tid = F.tid; asm volatile("" : "+v"(tid));
    for (int idx = tid; idx < 1024; idx += NTHR) { const int t = idx >> 4, r = idx & 15; LR[idx] = (t < nvalid) ? (float)Hb[(size_t)t * GLA_LD + 3072 + r] : 0.f; }
    for (int idx = tid; idx < 2048; idx += NTHR) { const int r = idx >> 7, d = idx & 127; WA2[idx] = wa2[r * 512 + h * 128 + d]; }
    __syncthreads();
    const int d = tid & 127, tq = tid >> 7;
    {
        float wreg[16];
#pragma unroll
        for (int r = 0; r < 16; ++r) wreg[r] = WA2[r * 128 + d];
        const float bad = ba[h * 128 + d];
        float run = 0.f;
#pragma unroll 2
        for (int i = 0; i < 16; ++i) { const int t = tq * 16 + i; float x = bad;
#pragma unroll
            for (int r = 0; r < 16; ++r) x += LR[t * 16 + r] * wreg[r];
            const float ls = fminf(x, 0.f) - __logf(1.f + __expf(-fabsf(x)));
            run += (t < nvalid) ? ls * (1.f / 16.f) : 0.f; BC[t * 128 + d] = run; }
        PSUM[tq * 128 + d] = run;
    }
    __syncthreads();
    float pre = 0.f, tot = 0.f;
#pragma unroll
    for (int q = 0; q < 4; ++q) { const float p = PSUM[q * 128 + d]; tot += p; pre += (q < tq) ? p : 0.f; }
    {
        const f16* hq = Hb + (size_t)(tq * 16) * GLA_LD + h * 128 + d;
        f16 qr[16], kr[16];
#pragma unroll
        for (int i = 0; i < 16; ++i) { const bool ok = tq * 16 + i < nvalid; qr[i] = ok ? hq[(size_t)i * GLA_LD] : (f16)0.f; kr[i] = ok ? hq[(size_t)i * GLA_LD + 512] : (f16)0.f; }
        const int c = tid & 255, th = tid >> 8; const f16* hv = Hb + (size_t)(th * 32) * GLA_LD + 1024 + h * 256 + c;
        h8 vv[4];
#pragma unroll
        for (int i = 0; i < 32; ++i) vv[i >> 3][i & 7] = (th * 32 + i < nvalid) ? hv[(size_t)i * GLA_LD] : (f16)0.f;
#pragma unroll
        for (int i = 0; i < 16; ++i) { const int t = tq * 16 + i; const float b = pre + BC[t * 128 + d]; const float q = (float)qr[i], k = (float)kr[i];
            QD[t * 136 + d] = (f16)(q * 0.08838834764831845f * __expf(b)); KI[t * 136 + d] = (f16)(k * __expf(-b)); KET[d * 72 + t] = (f16)(k * __expf(tot - b)); }
        if (tq == 0) EBL[d] = __expf(tot);
#pragma unroll
        for (int i = 0; i < 4; ++i) *(LAS h8*)(VT + c * 72 + th * 32 + 8 * i) = vv[i];
    }
    __syncthreads();
    {
        const int lane = tid & 63, fr = lane & 15, fq = lane >> 4;
#pragma unroll
        for (int tl = 0; tl < 2; ++tl) { const int tile = 2 * F.wave + tl, ti = tile >> 2, tj = tile & 3; f32x4 acc = {0.f, 0.f, 0.f, 0.f};
#pragma unroll
            for (int kk = 0; kk < 4; ++kk) { const h8 a = *(const LAS h8*)(QD + (ti * 16 + fr) * 136 + kk * 32 + 8 * fq), b = *(const LAS h8*)(KI + (tj * 16 + fr) * 136 + kk * 32 + 8 * fq); acc = MFMA16(a, b, acc); }
#pragma unroll
            for (int r = 0; r < 4; ++r) { const int i = ti * 16 + 4 * fq + r, jj = tj * 16 + fr; ATT[i * 72 + jj] = (f16)((jj <= i) ? acc[r] : 0.f); } }
    }
    __syncthreads();
    GAS u32x4* dst = (GAS u32x4*)(F.ws + WS_CHK + (size_t)item * GLA_CHK);
    for (int idx = tid; idx < GLA_CHK / 16; idx += NTHR) dst[idx] = ((const LAS u32x4*)L)[idx];
    __syncthreads();
}

constexpr int GA_OT = 2 * GA_STAGE, GA_OTB = 64 * 264 * 2;
static_assert(GA_OT + 2 * GA_OTB <= LDSCTL_OFF, "GLA scan LDS");
DI void gla_stage(const unsigned char* src, LAS unsigned char* dst, int wave, int lane) {
    for (int p = wave; p < GA_STAGE / 1024; p += NWAVES)
        __builtin_amdgcn_global_load_lds((const unsigned*)(src + p * 1024 + lane * 16), (LAS unsigned*)(dst + p * 1024), 16, 0, 0);
}
DI void gla_scan_seq(Frame& F, int j, int h, int blk0, int bstride, int nchunks, int row0, int nvalid, const float* S0, float* Sout) {
    LAS unsigned char* L = F.lds;
    const f16* Hb = (const f16*)(F.ws + WS_H); f16* OG = (f16*)(F.ws + WS_OG);
    const float* gnp = F.a->in[I_GLA_NG] + j * 256;
    const unsigned char* blk = F.ws + WS_CHK + (size_t)blk0 * GLA_CHK; const size_t bstep = (size_t)bstride * GLA_CHK;
    f32x16 S[4]; h8 vb[4];
    {
        const int lane = F.lane, l31 = lane & 31, hh = lane >> 5, c = 32 * F.wave + l31;
        gla_stage(blk, L, F.wave, lane);
#pragma unroll
        for (int ks = 0; ks < 4; ++ks) vb[ks] = *(const GAS h8*)((const f16*)(blk + GA_VT) + c * 72 + 16 * ks + 8 * hh);
#pragma unroll
        for (int dt = 0; dt < 4; ++dt)
#pragma unroll
            for (int r = 0; r < 16; ++r) { const int d = 32 * dt + (r & 3) + 8 * (r >> 2) + 4 * hh; S[dt][r] = S0 ? S0[(size_t)d * 256 + c] : 0.f; }
        VM_WAIT(); __syncthreads();
    }
#pragma unroll 1
    for (int n = 0; n < nchunks; ++n) {
        int tid = F.tid; asm volatile("" : "+v"(tid));
        const int lane = tid & 63, w = F.wave, l31 = lane & 31, hh = lane >> 5, c = 32 * w + l31;
        const LAS unsigned char* cur = L + (n & 1) * GA_STAGE;
        const LAS f16* ATT = (const LAS f16*)(cur + GA_ATT); const LAS f16* QD = (const LAS f16*)(cur + GA_QD); const LAS f16* KET = (const LAS f16*)(cur + GA_KET); const LAS float* EBL = (const LAS float*)(cur + GA_EBL);
        LAS f16* OT = (LAS f16*)(L + GA_OT + (n & 1) * GA_OTB);
        const bool more = n + 1 < nchunks;
        const unsigned char* nblk = blk + bstep;
        h8 vbn[4];
#pragma unroll
        for (int ks = 0; ks < 4; ++ks) vbn[ks] = more ? *(const GAS h8*)((const f16*)(nblk + GA_VT) + c * 72 + 16 * ks + 8 * hh) : vb[ks];
        const int et = tid >> 3, ec0 = (tid & 7) * 32; const size_t erow = (size_t)row0 + n * 64 + et;
        h8 rr[4];
#pragma unroll
        for (int i = 0; i < 4; ++i) rr[i] = (et < nvalid) ? *(const GAS h8*)(Hb + erow * GLA_LD + 2048 + h * 256 + ec0 + 8 * i) : vb[0];
        if (more) gla_stage(nblk, L + ((n + 1) & 1) * GA_STAGE, w, lane);
        f32x16 o[2];
#pragma unroll
        for (int it = 0; it < 2; ++it)
#pragma unroll
            for (int r = 0; r < 16; ++r) o[it][r] = 0.f;
#pragma unroll
        for (int dt = 0; dt < 4; ++dt)
#pragma unroll
            for (int s = 0; s < 2; ++s) { h8 sb;
#pragma unroll
                for (int e = 0; e < 8; ++e) sb[e] = (f16)S[dt][8 * s + e];
#pragma unroll
                for (int it = 0; it < 2; ++it) { const LAS f16* p = QD + (32 * it + l31) * 136 + 32 * dt + 16 * s + 4 * hh;
                    const h8 a = cat44(*(const LAS h4*)p, *(const LAS h4*)(p + 8)); o[it] = MFMA32(a, sb, o[it]); } }
#pragma unroll
        for (int ks = 0; ks < 4; ++ks)
#pragma unroll
            for (int it = 0; it < 2; ++it) { const h8 a = *(const LAS h8*)(ATT + (32 * it + l31) * 72 + 16 * ks + 8 * hh); o[it] = MFMA32(a, vb[ks], o[it]); }
#pragma unroll
        for (int it = 0; it < 2; ++it)
#pragma unroll
            for (int r = 0; r < 16; ++r) OT[(32 * it + (r & 3) + 8 * (r >> 2) + 4 * hh) * 264 + c] = (f16)o[it][r];
#pragma unroll
        for (int dt = 0; dt < 4; ++dt) {
#pragma unroll
            for (int r = 0; r < 16; ++r) S[dt][r] *= EBL[32 * dt + (r & 3) + 8 * (r >> 2) + 4 * hh];
#pragma unroll
            for (int ks = 0; ks < 4; ++ks) { const h8 a = *(const LAS h8*)(KET + (32 * dt + l31) * 72 + 16 * ks + 8 * hh); S[dt] = MFMA32(a, vb[ks], S[dt]); } }
        VM_WAIT(); __syncthreads();
        {
            h8 ov[4]; float ss = 0.f;
#pragma unroll
            for (int i = 0; i < 4; ++i) { ov[i] = *(const LAS h8*)(OT + et * 264 + ec0 + 8 * i);
#pragma unroll
                for (int e = 0; e < 8; ++e) { const float v = (float)ov[i][e]; ss += v * v; } }
            ss += __shfl_xor(ss, 1); ss += __shfl_xor(ss, 2); ss += __shfl_xor(ss, 4);
            const float rstd = 1.f / sqrtf(ss * (1.f / 256.f) + NORM_EPS);
            if (et < nvalid) {
#pragma unroll
                for (int i = 0; i < 4; ++i) { const f32x4 g0 = *(const f32x4*)(gnp + ec0 + 8 * i), g1 = *(const f32x4*)(gnp + ec0 + 8 * i + 4);
                    float ov_[8];
#pragma unroll
                    for (int e = 0; e < 8; ++e) ov_[e] = (float)ov[i][e] * rstd * (e < 4 ? g0[e] : g1[e - 4]) * siluf_((float)rr[i][e]);
                    u32x4 wv; wv.x = pkh(ov_[0], ov_[1]); wv.y = pkh(ov_[2], ov_[3]); wv.z = pkh(ov_[4], ov_[5]); wv.w = pkh(ov_[6], ov_[7]);
                    *(GAS u32x4*)(OG + erow * DM + h * 256 + ec0 + 8 * i) = wv; } }
        }
#pragma unroll
        for (int ks = 0; ks < 4; ++ks) vb[ks] = vbn[ks];
        blk = nblk;
    }
    {
        const int lane = F.lane, l31 = lane & 31, hh = lane >> 5, c = 32 * F.wave + l31;
#pragma unroll
        for (int dt = 0; dt < 4; ++dt)
#pragma unroll
            for (int r = 0; r < 16; ++r) { const int d = 32 * dt + (r & 3) + 8 * (r >> 2) + 4 * hh; Sout[(size_t)d * 256 + c] = S[dt][r]; }
    }
    __syncthreads();
}
DI void gla_pre_phase(Frame& F, int j) { for (int it = F.bid; it < 1536; it += F.G) gla_pre_item(F, j, it); }
DI void gla_scan_phase(Frame& F, int j) {
    const float* S0all = F.a->in[I_SGLA] + (size_t)j * 128 * 4 * 128 * 256;
    float* pout = F.out + O_PGLA + (size_t)j * 8 * 4 * 128 * 256; float* sout = F.out + O_SGLA + (size_t)j * 128 * 4 * 128 * 256;
    if (F.bid < 32 && F.bid < F.G) { const int b = F.bid >> 2, h = F.bid & 3; gla_scan_seq(F, j, h, b * 128 + h, 4, 32, b * 2048, 64, nullptr, pout + (size_t)(b * 4 + h) * 128 * 256); }
    const int first = (F.G > 64) ? 32 : 0, nw = F.G - first;
    if (F.bid >= first) for (int s = F.bid - first; s < 512; s += nw) { const int b = s >> 2, h = s & 3;
        gla_scan_seq(F, j, h, 1024 + s, 0, 1, MP + b * 8, 8, S0all + (size_t)s * 128 * 256, sout + (size_t)s * 128 * 256); }
}

constexpr int GD_KN = GDN_CHK, GD_QN = GD_KN + 18432, GD_AMAT = GD_QN + 18432, GD_P = GD_AMAT + 64 * 68 * 4, GD_TM = GD_P + 4096, GD_SC = GD_TM + 9216;
static_assert(GD_SC + 1024 <= LDSCTL_OFF, "GDN pre-phase LDS");
DI float softplusf_(float x) { return fmaxf(x, 0.f) + __logf(1.f + __expf(-fabsf(x))); }

DI void gdn_pre_item(Frame& F, int item) {
    LAS unsigned char* L = F.lds;
    LAS f16* ATT = (LAS f16*)(L + GD_ATT); LAS f16* QD = (LAS f16*)(L + GD_QD); LAS f16* NW = (LAS f16*)(L + GD_NW); LAS f16* KET = (LAS f16*)(L + GD_KET); LAS f16* UT = (LAS f16*)(L + GD_UT);
    LAS float* GEp = (LAS float*)(L + GD_GE);
    LAS f16* KN = (LAS f16*)(L + GD_KN); LAS f16* QN = (LAS f16*)(L + GD_QN); LAS f16* R2T = KN; LAS f16* R1T = QN;
    LAS float* AMAT = (LAS float*)(L + GD_AMAT); LAS float* TI = (LAS float*)(L + GD_UT); LAS float* P = (LAS float*)(L + GD_P); LAS f16* TM = (LAS f16*)(L + GD_TM);
    LAS float* Gs = (LAS float*)(L + GD_SC); LAS float* BETA = Gs + 64; LAS float* GC = Gs + 128; LAS float* SB2 = Gs + 192;
    int row0, nvalid, h, first, bs = 0;
    if (item < 2048) { const int b = item >> 8, n = (item >> 3) & 31; h = item & 7; row0 = b * 2048 + n * 64; nvalid = 64; first = (n == 0); }
    else { const int s = item - 2048; h = s & 7; bs = s >> 3; row0 = MP + bs * 8; nvalid = 8; first = 2; }
    const f16* Hb = (const f16*)(F.ws + WS_H) + (size_t)row0 * GDN_LD;
    const float* wconv = F.a->in[I_GDN_WCONV]; const float* conv0 = F.a->in[I_SCONV] + (size_t)bs * 3 * 3072;
    int tid = F.tid; asm volatile("" : "+v"(tid));
    const int t = tid >> 3, dseg = tid & 7, d0 = dseg * 16;
    const int lane = tid & 63, fr = lane & 15, fq = lane >> 4;
    LAS f16* RAW = (LAS f16*)L; LAS float* WC = (LAS float*)(L + 67 * 784);
    float ga = 0.f, gb = 0.f;
    if (dseg == 0 && t < nvalid) { ga = (float)Hb[(size_t)t * GDN_LD + 4096 + h]; gb = (float)Hb[(size_t)t * GDN_LD + 4104 + h]; }
    for (int idx = tid; idx < 67 * 48; idx += NTHR) { const int rr = idx / 48, ch = idx - rr * 48, X = ch >> 4, cc = (ch & 15) * 8, tp = rr - 3, col = X * 1024 + h * 128 + cc;
        if (tp < nvalid) { u32x4 v = {0u, 0u, 0u, 0u};
            if (tp >= 0 || first == 0) v = *(const GAS u32x4*)(Hb + (ptrdiff_t)tp * GDN_LD + col);
            else if (first == 2) { const f32x4 a = *(const f32x4*)(conv0 + (size_t)(3 + tp) * 3072 + col), b = *(const f32x4*)(conv0 + (size_t)(3 + tp) * 3072 + col + 4); v.x = pkh(a.x, a.y); v.y = pkh(a.z, a.w); v.z = pkh(b.x, b.y); v.w = pkh(b.z, b.w); }
            *(LAS u32x4*)(RAW + rr * 392 + X * 128 + cc) = v; } }
    for (int idx = tid; idx < 1536; idx += NTHR) { const int X = idx >> 9, i = (idx >> 7) & 3, d = idx & 127; WC[idx] = wconv[(size_t)i * 3072 + X * 1024 + h * 128 + d]; }
    __syncthreads();
    float qv[16], kv[16], vv[16];
    {
#pragma unroll
        for (int X = 0; X < 3; ++X) {
            float acc[16];
#pragma unroll
            for (int e = 0; e < 16; ++e) acc[e] = 0.f;
            if (t < nvalid) {
#pragma unroll
            for (int i = 0; i < 4; ++i) {
                const h8 a = *(const LAS h8*)(RAW + (t + i) * 392 + X * 128 + d0), b = *(const LAS h8*)(RAW + (t + i) * 392 + X * 128 + d0 + 8);
                const LAS float* wp = WC + (X * 4 + i) * 128 + d0;
#pragma unroll
                for (int e = 0; e < 8; ++e) { acc[e] += wp[e] * (float)a[e]; acc[8 + e] += wp[8 + e] * (float)b[e]; } }
            }
            const bool ok = t < nvalid;
#pragma unroll
            for (int e = 0; e < 16; ++e) { const float s = ok ? siluf_(acc[e]) : 0.f; if (X == 0) qv[e] = s; else if (X == 1) kv[e] = s; else vv[e] = s; }
        }
        float sq = 0.f, sk = 0.f;
#pragma unroll
        for (int e = 0; e < 16; ++e) { sq += qv[e] * qv[e]; sk += kv[e] * kv[e]; }
        sq += __shfl_xor(sq, 1); sq += __shfl_xor(sq, 2); sq += __shfl_xor(sq, 4);
        sk += __shfl_xor(sk, 1); sk += __shfl_xor(sk, 2); sk += __shfl_xor(sk, 4);
        const float rq = 0.08838834764831845f / sqrtf(sq + NORM_EPS), rk = 1.f / sqrtf(sk + NORM_EPS);
        u32x4 pq[2], pk[2];
#pragma unroll
        for (int e = 0; e < 16; ++e) { qv[e] *= rq; kv[e] *= rk; }
#pragma unroll
        for (int e = 0; e < 4; ++e) { pq[0][e] = pkh(qv[2 * e], qv[2 * e + 1]); pq[1][e] = pkh(qv[8 + 2 * e], qv[8 + 2 * e + 1]); pk[0][e] = pkh(kv[2 * e], kv[2 * e + 1]); pk[1][e] = pkh(kv[8 + 2 * e], kv[8 + 2 * e + 1]); }
        *(LAS u32x4*)(QN + t * 136 + d0) = pq[0]; *(LAS u32x4*)(QN + t * 136 + d0 + 8) = pq[1];
        *(LAS u32x4*)(KN + t * 136 + d0) = pk[0]; *(LAS u32x4*)(KN + t * 136 + d0 + 8) = pk[1];
        if (dseg == 0) { float g = 0.f, be = 0.f;
            if (t < nvalid) { g = -__expf(F.a->in[I_GDN_ALOG][h]) * softplusf_(ga + F.a->in[I_GDN_DTB][h]); be = sigmoidf_(gb); }
            Gs[t] = g; BETA[t] = be; }
    }
    __syncthreads();
    if (tid < 64) { float v = Gs[tid];
#pragma unroll
        for (int o = 1; o < 64; o <<= 1) { const float u = __shfl_up(v, o); if (tid >= o) v += u; }
        GC[tid] = v; SB2[tid] = BETA[tid] * __expf(v);
        if (tid == 63) GEp[0] = __expf(v); }
    __syncthreads();
    {
#pragma unroll
        for (int tl = 0; tl < 2; ++tl) { const int tile = 2 * F.wave + tl, ti = tile >> 2, tj = tile & 3; f32x4 akk = {0.f, 0.f, 0.f, 0.f}, aqk = {0.f, 0.f, 0.f, 0.f};
#pragma unroll
            for (int kk = 0; kk < 4; ++kk) { const h8 b = *(const LAS h8*)(KN + (tj * 16 + fr) * 136 + kk * 32 + 8 * fq);
                const h8 a1 = *(const LAS h8*)(KN + (ti * 16 + fr) * 136 + kk * 32 + 8 * fq), a2 = *(const LAS h8*)(QN + (ti * 16 + fr) * 136 + kk * 32 + 8 * fq);
                akk = MFMA16(a1, b, akk); aqk = MFMA16(a2, b, aqk); }
#pragma unroll
            for (int r = 0; r < 4; ++r) { const int i = ti * 16 + 4 * fq + r, jj = tj * 16 + fr; const float dec = (jj <= i) ? __expf(GC[i] - GC[jj]) : 0.f;
                AMAT[i * 68 + jj] = (jj < i) ? BETA[i] * akk[r] * dec : 0.f; ATT[i * 72 + jj] = (f16)(aqk[r] * dec); } }
        const float eg = __expf(GC[t]), ee = __expf(GC[63] - GC[t]);
        u32x4 pq[2];
#pragma unroll
        for (int e = 0; e < 4; ++e) { pq[0][e] = pkh(qv[2 * e] * eg, qv[2 * e + 1] * eg); pq[1][e] = pkh(qv[8 + 2 * e] * eg, qv[8 + 2 * e + 1] * eg); }
        *(LAS u32x4*)(QD + t * 136 + d0) = pq[0]; *(LAS u32x4*)(QD + t * 136 + d0 + 8) = pq[1];
#pragma unroll
        for (int e = 0; e < 16; ++e) KET[(d0 + e) * 72 + t] = (f16)(kv[e] * ee);
    }
    __syncthreads();
    {
        const float b1 = BETA[t], b2 = SB2[t];
#pragma unroll
        for (int e = 0; e < 16; ++e) { R1T[(d0 + e) * 72 + t] = (f16)(b1 * vv[e]); R2T[(d0 + e) * 72 + t] = (f16)(b2 * kv[e]); }
        if (tid < 64) {
            const int bI = tid >> 4, cc = tid & 15; float x[16];
#pragma unroll
            for (int i = 0; i < 16; ++i) { float acc = (i == cc) ? 1.f : 0.f;
#pragma unroll
                for (int jj = 0; jj < i; ++jj) acc -= AMAT[(16 * bI + i) * 68 + 16 * bI + jj] * x[jj];
                x[i] = acc; }
#pragma unroll
            for (int i = 0; i < 16; ++i) TI[(16 * bI + i) * 68 + 16 * bI + cc] = x[i];
        }
    }
    __syncthreads();
    {
        const int pr = tid >> 8, i = (tid >> 4) & 15, cc = tid & 15, rb = 32 * pr; float acc = 0.f;
#pragma unroll
        for (int k = 0; k < 16; ++k) acc += AMAT[(rb + 16 + i) * 68 + rb + k] * TI[(rb + k) * 68 + rb + cc];
        P[pr * 256 + i * 16 + cc] = acc;
        __syncthreads();
        float q = 0.f;
#pragma unroll
        for (int k = 0; k < 16; ++k) q -= TI[(rb + 16 + i) * 68 + rb + 16 + k] * P[pr * 256 + k * 16 + cc];
        TI[(rb + 16 + i) * 68 + rb + cc] = q;
    }
    __syncthreads();
    {
        const int i = tid >> 4, c2 = (tid & 15) * 2;
        float a0 = 0.f, a1 = 0.f;
#pragma unroll 8
        for (int k = 0; k < 32; ++k) { const float a = AMAT[(32 + i) * 68 + k]; a0 += (k >= c2) ? a * TI[k * 68 + c2] : 0.f; a1 += (k >= c2 + 1) ? a * TI[k * 68 + c2 + 1] : 0.f; }
        P[i * 32 + c2] = a0; P[i * 32 + c2 + 1] = a1;
        __syncthreads();
        float q0 = 0.f, q1 = 0.f;
#pragma unroll 8
        for (int k = 0; k < 32; ++k) { const float tv = (k <= i) ? TI[(32 + i) * 68 + 32 + k] : 0.f; q0 -= tv * P[k * 32 + c2]; q1 -= tv * P[k * 32 + c2 + 1]; }
        TI[(32 + i) * 68 + c2] = q0; TI[(32 + i) * 68 + c2 + 1] = q1;
    }
    __syncthreads();
    for (int idx = tid; idx < 4096; idx += NTHR) { const int i = idx >> 6, jj = idx & 63; TM[i * 72 + jj] = (f16)((jj <= i) ? TI[i * 68 + jj] : 0.f); }
    __syncthreads();
    {
#pragma unroll
        for (int cl = 0; cl < 2; ++cl) { const int ct = 2 * F.wave + cl; const bool isw = ct >= 8; const LAS f16* RT = isw ? R2T : R1T; const int cb = (ct & 7) * 16;
            h8 bf[2];
#pragma unroll
            for (int k2 = 0; k2 < 2; ++k2) bf[k2] = *(const LAS h8*)(RT + (cb + fr) * 72 + 32 * k2 + 8 * fq);
#pragma unroll
            for (int tt = 0; tt < 4; ++tt) { f32x4 acc = {0.f, 0.f, 0.f, 0.f};
#pragma unroll
                for (int k2 = 0; k2 < 2; ++k2) { const h8 a = *(const LAS h8*)(TM + (16 * tt + fr) * 72 + 32 * k2 + 8 * fq); acc = MFMA16(a, bf[k2], acc); }
                if (!isw) { u32x2 o; o.x = pkh(acc[0], acc[1]); o.y = pkh(acc[2], acc[3]); *(LAS u32x2*)(UT + (cb + fr) * 72 + 16 * tt + 4 * fq) = o; }
                else {
#pragma unroll
                    for (int r = 0; r < 4; ++r) NW[(16 * tt + 4 * fq + r) * 136 + cb + fr] = (f16)(-acc[r]); } } }
    }
    __syncthreads();
    GAS u32x4* dst = (GAS u32x4*)(F.ws + WS_CHK + (size_t)item * GDN_CHK);
    for (int idx = tid; idx < GDN_CHK / 16; idx += NTHR) dst[idx] = ((const LAS u32x4*)L)[idx];
    __syncthreads();
}

constexpr int GD_OT = 2 * GD_STAGE, GD_OTB = 64 * 136 * 2;
static_assert(GD_OT + 2 * GD_OTB <= LDSCTL_OFF, "GDN scan LDS");
DI void gdn_stage(const unsigned char* src, LAS unsigned char* dst, int wave, int lane) {
    for (int p = wave; p < GD_STAGE / 1024; p += NWAVES)
        __builtin_amdgcn_global_load_lds((const unsigned*)(src + p * 1024 + lane * 16), (LAS unsigned*)(dst + p * 1024), 16, 0, 0);
}
DI void gdn_scan_seq(Frame& F, int h, int blk0, int bstride, int nchunks, int row0, int nvalid, const float* S0, float* Sout) {
    LAS unsigned char* L = F.lds;
    const f16* Hb = (const f16*)(F.ws + WS_H); f16* OG = (f16*)(F.ws + WS_OG);
    const float* gnp = F.a->in[I_GDN_NG];
    const unsigned char* blk = F.ws + WS_CHK + (size_t)blk0 * GDN_CHK; const size_t bstep = (size_t)bstride * GDN_CHK;
    f32x4 S[8]; h4 uu[4];
    {
        const int lane = F.lane, fr = lane & 15, fq = lane >> 4, c = 16 * F.wave + fr;
        gdn_stage(blk, L, F.wave, lane);
#pragma unroll
        for (int tt = 0; tt < 4; ++tt) uu[tt] = *(const GAS h4*)((const f16*)(blk + GD_UT) + c * 72 + 16 * tt + 4 * fq);
#pragma unroll
        for (int dt = 0; dt < 8; ++dt)
#pragma unroll
            for (int r = 0; r < 4; ++r) { const int d = 16 * dt + 4 * fq + r; S[dt][r] = S0 ? S0[(size_t)d * 128 + c] : 0.f; }
        VM_WAIT(); __syncthreads();
    }
#pragma unroll 1
    for (int n = 0; n < nchunks; ++n) {
        int tid = F.tid; asm volatile("" : "+v"(tid));
        const int lane = tid & 63, w = F.wave, fr = lane & 15, fq = lane >> 4, c = 16 * w + fr;
        const LAS unsigned char* cur = L + (n & 1) * GD_STAGE;
        const LAS f16* ATT = (const LAS f16*)(cur + GD_ATT); const LAS f16* QD = (const LAS f16*)(cur + GD_QD); const LAS f16* NW = (const LAS f16*)(cur + GD_NW); const LAS f16* KET = (const LAS f16*)(cur + GD_KET);
        const LAS float* GEp = (const LAS float*)(cur + GD_GE);
        LAS f16* OT = (LAS f16*)(L + GD_OT + (n & 1) * GD_OTB);
        const bool more = n + 1 < nchunks;
        const unsigned char* nblk = blk + bstep;
        h4 un[4];
#pragma unroll
        for (int tt = 0; tt < 4; ++tt) un[tt] = more ? *(const GAS h4*)((const f16*)(nblk + GD_UT) + c * 72 + 16 * tt + 4 * fq) : uu[tt];
        const int et = tid >> 3, ec0 = (tid & 7) * 16; const size_t erow = (size_t)row0 + n * 64 + et;
        h8 zz[2];
#pragma unroll
        for (int i = 0; i < 2; ++i) zz[i] = (et < nvalid) ? *(const GAS h8*)(Hb + erow * GDN_LD + 3072 + h * 128 + ec0 + 8 * i) : cat44(uu[0], uu[1]);
        if (more) gdn_stage(nblk, L + ((n + 1) & 1) * GD_STAGE, w, lane);
        const float ge = GEp[0];
        h8 sb[4];
#pragma unroll
        for (int ks = 0; ks < 4; ++ks)
#pragma unroll
            for (int e = 0; e < 4; ++e) { sb[ks][e] = (f16)S[2 * ks][e]; sb[ks][4 + e] = (f16)S[2 * ks + 1][e]; }
        f32x4 vn[4], o[4];
#pragma unroll
        for (int tt = 0; tt < 4; ++tt) {
            vn[tt] = (f32x4){(float)uu[tt][0], (float)uu[tt][1], (float)uu[tt][2], (float)uu[tt][3]}; o[tt] = (f32x4){0.f, 0.f, 0.f, 0.f};
#pragma unroll
            for (int ks = 0; ks < 4; ++ks) { const LAS f16* p = NW + (16 * tt + fr) * 136 + 32 * ks + 4 * fq; const LAS f16* q = QD + (16 * tt + fr) * 136 + 32 * ks + 4 * fq;
                vn[tt] = MFMA16(cat44(*(const LAS h4*)p, *(const LAS h4*)(p + 16)), sb[ks], vn[tt]);
                o[tt] = MFMA16(cat44(*(const LAS h4*)q, *(const LAS h4*)(q + 16)), sb[ks], o[tt]); } }
        h8 vb[2];
#pragma unroll
        for (int k2 = 0; k2 < 2; ++k2)
#pragma unroll
            for (int e = 0; e < 4; ++e) { vb[k2][e] = (f16)vn[2 * k2][e]; vb[k2][4 + e] = (f16)vn[2 * k2 + 1][e]; }
#pragma unroll
        for (int tt = 0; tt < 4; ++tt)
#pragma unroll
            for (int k2 = 0; k2 < 2; ++k2) { const LAS f16* p = ATT + (16 * tt + fr) * 72 + 32 * k2 + 4 * fq; o[tt] = MFMA16(cat44(*(const LAS h4*)p, *(const LAS h4*)(p + 16)), vb[k2], o[tt]); }
#pragma unroll
        for (int tt = 0; tt < 4; ++tt)
#pragma unroll
            for (int r = 0; r < 4; ++r) OT[(16 * tt + 4 * fq + r) * 136 + c] = (f16)o[tt][r];
#pragma unroll
        for (int dt = 0; dt < 8; ++dt) { S[dt] = S[dt] * ge;
#pragma unroll
            for (int k2 = 0; k2 < 2; ++k2) { const LAS f16* p = KET + (16 * dt + fr) * 72 + 32 * k2 + 4 * fq; S[dt] = MFMA16(cat44(*(const LAS h4*)p, *(const LAS h4*)(p + 16)), vb[k2], S[dt]); } }
        VM_WAIT(); __syncthreads();
        {
            h8 ov[2]; float ss = 0.f;
#pragma unroll
            for (int i = 0; i < 2; ++i) { ov[i] = *(const LAS h8*)(OT + et * 136 + ec0 + 8 * i);
#pragma unroll
                for (int e = 0; e < 8; ++e) { const float v = (float)ov[i][e]; ss += v * v; } }
            ss += __shfl_xor(ss, 1); ss += __shfl_xor(ss, 2); ss += __shfl_xor(ss, 4);
            const float rstd = 1.f / sqrtf(ss * (1.f / 128.f) + NORM_EPS);
            if (et < nvalid) {
#pragma unroll
                for (int i = 0; i < 2; ++i) { const f32x4 g0 = *(const f32x4*)(gnp + ec0 + 8 * i), g1 = *(const f32x4*)(gnp + ec0 + 8 * i + 4);
                    float ov_[8];
#pragma unroll
                    for (int e = 0; e < 8; ++e) ov_[e] = (float)ov[i][e] * rstd * (e < 4 ? g0[e] : g1[e - 4]) * siluf_((float)zz[i][e]);
                    u32x4 wv; wv.x = pkh(ov_[0], ov_[1]); wv.y = pkh(ov_[2], ov_[3]); wv.z = pkh(ov_[4], ov_[5]); wv.w = pkh(ov_[6], ov_[7]);
                    *(GAS u32x4*)(OG + erow * DM + h * 128 + ec0 + 8 * i) = wv; } }
        }
#pragma unroll
        for (int tt = 0; tt < 4; ++tt) uu[tt] = un[tt];
        blk = nblk;
    }
    {
        const int lane = F.lane, fr = lane & 15, fq = lane >> 4, c = 16 * F.wave + fr;
#pragma unroll
        for (int dt = 0; dt < 8; ++dt)
#pragma unroll
            for (int r = 0; r < 4; ++r) { const int d = 16 * dt + 4 * fq + r; Sout[(size_t)d * 128 + c] = S[dt][r]; }
    }
    __syncthreads();
}
DI void gdn_pre_phase(Frame& F) {
    for (int it = F.bid; it < 3072; it += F.G) gdn_pre_item(F, it);
    const f16* Hb = (const f16*)(F.ws + WS_H);
    const int gt = F.bid * NTHR + F.tid, NT = F.G * NTHR;
    for (int idx = gt; idx < 8 * 3 * 3072; idx += NT) { const int ch = idx % 3072, i = (idx / 3072) % 3, b = idx / (3 * 3072); F.out[O_PCONV + idx] = (float)Hb[(size_t)(b * 2048 + 2045 + i) * GDN_LD + ch]; }
    for (int idx = gt; idx < 128 * 3 * 3072; idx += NT) { const int ch = idx % 3072, i = (idx / 3072) % 3, b = idx / (3 * 3072); F.out[O_SCONV + idx] = (float)Hb[(size_t)(MP + b * 8 + 5 + i) * GDN_LD + ch]; }
}
DI void gdn_scan_phase(Frame& F) {
    const float* S0all = F.a->in[I_SGDN]; float* pout = F.out + O_PGDN; float* sout = F.out + O_SGDN;
    if (F.bid < 64 && F.bid < F.G) { const int b = F.bid >> 3, h = F.bid & 7; gdn_scan_seq(F, h, b * 256 + h, 8, 32, b * 2048, 64, nullptr, pout + (size_t)(b * 8 + h) * 128 * 128); }
    const int first = (F.G > 128) ? 64 : 0, nw = F.G - first;
    if (F.bid >= first) for (int s = F.bid - first; s < 1024; s += nw) { const int b = s >> 3, h = s & 7;
        gdn_scan_seq(F, h, 2048 + s, 0, 1, MP + b * 8, 8, S0all + (size_t)s * 128 * 128, sout + (size_t)s * 128 * 128); }
}

constexpr int S5_HS_BYTES = 32 * 136 * 2;
DI float gelu_tanh(float x) { const float z = 0.7978845608028654f * (x + 0.044715f * x * x * x); const float e = __expf(2.f * z); return 0.5f * x * (1.f + (1.f - 2.f / (e + 1.f))); }

DI void s5_seq(Frame& F, int g, int row0, int Lsteps, const float* h0re, const float* h0im, float* ore, float* oim) {
    const Args& A = *F.a;
    const int lane = F.lane, l31 = lane & 31, hh = lane >> 5, fr = lane & 15, fq = lane >> 4;
    LAS f16* HS = (LAS f16*)(F.lds + F.wave * S5_HS_BYTES);
    const f16* Hb = (const f16*)(F.ws + WS_H); f16* Y = (f16*)(F.ws + WS_OG);
    const float dt = __expf(A.in[I_S5_LDT][g]), idt = 1.f / dt;
    float abr[2], abi[2], hre[2], him[2]; h8 bfr[4], cfr[4];
#pragma unroll
    for (int s = 0; s < 2; ++s) { const int p = l31 + 32 * s;
        const float lr = A.in[I_S5_LRE][g * 64 + p], li = A.in[I_S5_LIM][g * 64 + p];
        const float mag = expf(lr * dt); float sn, cs; sincosf(li * dt, &sn, &cs);
        abr[s] = mag * cs; abi[s] = mag * sn;
        const float den = lr * lr + li * li, nr = abr[s] - 1.f;
        const float cr = (nr * lr + abi[s] * li) / den * idt, ci = (abi[s] * lr - nr * li) / den * idt;
        const float* br = A.in[I_S5_BRE] + (size_t)(g * 64 + p) * 16 + 8 * hh; const float* bi = A.in[I_S5_BIM] + (size_t)(g * 64 + p) * 16 + 8 * hh;
#pragma unroll
        for (int e = 0; e < 8; ++e) { bfr[2 * s][e] = (f16)(cr * br[e] - ci * bi[e]); bfr[2 * s + 1][e] = (f16)(cr * bi[e] + ci * br[e]); }
        hre[s] = h0re ? h0re[g * 64 + p] : 0.f; him[s] = h0im ? h0im[g * 64 + p] : 0.f; }
#pragma unroll
    for (int ks = 0; ks < 4; ++ks)
#pragma unroll
        for (int e = 0; e < 8; ++e) { const int k = 32 * ks + 8 * fq + e, p = k >> 1;
            cfr[ks][e] = (k & 1) ? (f16)(-A.in[I_S5_CIM][(size_t)(g * 16 + fr) * 64 + p]) : (f16)(A.in[I_S5_CRE][(size_t)(g * 16 + fr) * 64 + p]); }
    const float dvec = A.in[I_S5_D][g * 16 + fr];
    for (int t0 = 0; t0 < Lsteps; t0 += 32) {
        h8 a;
        if (t0 + l31 < Lsteps) a = *(const GAS h8*)(Hb + (size_t)(row0 + t0 + l31) * S5_LD + g * 16 + 8 * hh);
        else {
#pragma unroll
            for (int e = 0; e < 8; ++e) a[e] = (f16)0.f; }
        f32x16 bu[4];
#pragma unroll
        for (int n = 0; n < 4; ++n) {
#pragma unroll
            for (int r = 0; r < 16; ++r) bu[n][r] = 0.f;
            bu[n] = MFMA32(a, bfr[n], bu[n]); }
        const int ngrp = (Lsteps - t0 >= 32) ? 8 : ((Lsteps - t0) >> 2);
#pragma unroll
        for (int gi = 0; gi < 8; ++gi) {
            if (gi < ngrp) {
                const bool own = (hh == (gi & 1));
#pragma unroll
                for (int s = 0; s < 2; ++s) { float re = hre[s], im = him[s];
#pragma unroll
                    for (int r = 0; r < 4; ++r) { const int reg = 4 * (gi >> 1) + r;
                        const float nre = abr[s] * re - abi[s] * im + bu[2 * s][reg] * dt, nim = abr[s] * im + abi[s] * re + bu[2 * s + 1][reg] * dt;
                        re = nre; im = nim;
                        bu[2 * s][reg] = own ? re : bu[2 * s][reg]; bu[2 * s + 1][reg] = own ? im : bu[2 * s + 1][reg]; }
                    const float xr = __shfl_xor(re, 32), xi = __shfl_xor(im, 32);
                    hre[s] = own ? re : xr; him[s] = own ? im : xi; }
            }
        }
#pragma unroll
        for (int s = 0; s < 2; ++s)
#pragma unroll
            for (int r = 0; r < 16; ++r) { const int t = (r & 3) + 8 * (r >> 2) + 4 * hh; *(LAS unsigned*)(HS + t * 136 + 2 * (l31 + 32 * s)) = pkh(bu[2 * s][r], bu[2 * s + 1][r]); }
        LDS_WAIT(); __builtin_amdgcn_wave_barrier();
        f32x4 y[2];
#pragma unroll
        for (int mt = 0; mt < 2; ++mt) { y[mt] = (f32x4){0.f, 0.f, 0.f, 0.f};
#pragma unroll
            for (int ks = 0; ks < 4; ++ks) { const h8 ha = *(const LAS h8*)(HS + (16 * mt + fr) * 136 + 32 * ks + 8 * fq); y[mt] = MFMA16(ha, cfr[ks], y[mt]); } }
        LDS_WAIT(); __builtin_amdgcn_wave_barrier();
#pragma unroll
        for (int mt = 0; mt < 2; ++mt)
#pragma unroll
            for (int r = 0; r < 4; ++r) { const int t = t0 + 16 * mt + 4 * fq + r;
                if (t < Lsteps) { const size_t row = (size_t)row0 + t; const float u = (float)Hb[row * S5_LD + g * 16 + fr];
                    Y[row * DM + g * 16 + fr] = (f16)gelu_tanh(y[mt][r] + dvec * u); } }
    }
    if (hh == 0) {
#pragma unroll
        for (int s = 0; s < 2; ++s) { ore[g * 64 + l31 + 32 * s] = hre[s]; oim[g * 64 + l31 + 32 * s] = him[s]; } }
}
DI void s5_scan_phase(Frame& F) {
    const Args& A = *F.a;
    if (F.wave < 2) {
        for (int sid = F.bid * 2 + F.wave; sid < 512; sid += F.G * 2) { const int b = sid >> 6, g = sid & 63;
            s5_seq(F, g, b * 2048, 2048, nullptr, nullptr, F.out + O_PS5R + (size_t)b * 4096, F.out + O_PS5I + (size_t)b * 4096); }
    } else {
        for (int sid = F.bid * 6 + (F.wave - 2); sid < 8192; sid += F.G * 6) { const int b = sid >> 6, g = sid & 63;
            s5_seq(F, g, MP + b * 8, 8, A.in[I_SS5R] + (size_t)b * 4096, A.in[I_SS5I] + (size_t)b * 4096, F.out + O_SS5R + (size_t)b * 4096, F.out + O_SS5I + (size_t)b * 4096); }
    }
}

#ifndef MK_PER_PHASE
#define MK_PER_PHASE 0
#endif
constexpr int N_PHASES = 21;
__global__ void __launch_bounds__(NTHR, 2) fwd_kernel(Args args) {
    extern __shared__ __attribute__((aligned(16))) unsigned char lds_raw[];
    Frame F;
    F.lds = (LAS unsigned char*)lds_raw;
    F.tid = threadIdx.x; F.lane = F.tid & 63; F.wave = __builtin_amdgcn_readfirstlane(F.tid >> 6);
    F.G = gridDim.x; F.bid = blockIdx.x; F.a = &args; F.ws = args.ws; F.out = args.out;
    volatile LAS unsigned* MISC = (volatile LAS unsigned*)(F.lds + LDSCTL_OFF);
    for (int u = F.tid; u < (LDS_BYTES - LDSCTL_OFF) / 4; u += NTHR) MISC[u] = 0u;
    __syncthreads();
    XcdBarrier bar; bar.bar = (unsigned*)(F.ws + WS_CTL) + CW_BAR; bar.x = 0; bar.st = nullptr;
    if (!MK_PER_PHASE) bar = xcd_barrier_post((unsigned*)(F.ws + WS_CTL) + CW_BAR, MISC + 8);
    const int lo = args.ph_lo, hi = args.ph_hi;
    LAS unsigned char* lds = F.lds;
    f16* X16 = (f16*)(F.ws + WS_X16); f16* Hbuf = (f16*)(F.ws + WS_H); f16* OGb = (f16*)(F.ws + WS_OG); float* Fb = (float*)(F.ws + WS_F); f16* YG = (f16*)(F.ws + WS_YG);
#define IN(k) (lo <= (k) && (k) < hi)
#define SEAM(k) do { if (!MK_PER_PHASE && IN((k) + 1)) xcd_barrier(bar); } while (0)
#define GEMM_F16(Aop, Wt, N, Out, ldo) do { pg8::Gemm g_{(Aop), (Wt), M, (N), DM}; pg8::StaticOrder S_; S_.init(M, (N), F.G, F.bid); pg8::EpiF16 E_{(Out), (ldo)}; \
        pg8::gemm_phase<pg8::EpiF16, pg8::StaticOrder, true, true>(lds, g_, S_, E_, F.tid); } while (0)
#define GEMM_F32(Aop, Wt, Out) do { pg8::Gemm g_{(Aop), (Wt), M, DM, DM}; pg8::StaticOrder S_; S_.init(M, DM, F.G, F.bid); pg8::EpiF32 E_{(Out), DM}; \
        pg8::gemm_phase<pg8::EpiF32, pg8::StaticOrder, true, true>(lds, g_, S_, E_, F.tid); } while (0)

#define PH_BEGIN() do { int t_ = threadIdx.x; asm volatile("" : "+v"(t_)); F.tid = t_; F.lane = t_ & 63; F.wave = __builtin_amdgcn_readfirstlane(t_ >> 6); } while (0)
#ifndef DUP_PH
#define DUP_PH -1
#endif
#define PHASE(k, body) do { if (IN(k)) { PH_BEGIN(); body; if (DUP_PH == (k)) { __syncthreads(); PH_BEGIN(); body; } SEAM(k); } } while (0)
#define GLA_LAYER(jl, p0, layer) do { \
        PHASE(p0, GEMM_F16(X16, (const f16*)(F.ws + WS_WGLAIN + (jl) * SZ_WGLAIN), GLA_LD, Hbuf, GLA_LD)); \
        PHASE(p0 + 1, gla_pre_phase(F, jl)); \
        PHASE(p0 + 2, gla_scan_phase(F, jl)); \
        PHASE(p0 + 3, GEMM_F32(OGb, (const f16*)(F.ws + WS_WGLAOUT + (jl) * SZ_W1K), Fb)); \
        if (IN(p0 + 4)) { PH_BEGIN(); ln_phase(F, layer, (layer) == 3); SEAM(p0 + 4); } } while (0)
#define GEMM_GLU() do { pg8::Gemm g_{OGb, (const f16*)(F.ws + WS_WS5GLU), M, 2048, DM}; pg8::StaticOrder S_; S_.init(M, 2048, F.G, F.bid); \
                  pg8::EpiGlu E_{YG, Hbuf + 1024, S5_LD, args.in[I_S5_BGLU]}; \
                  pg8::gemm_phase<pg8::EpiGlu, pg8::StaticOrder, true, true>(lds, g_, S_, E_, F.tid); } while (0)

    PHASE(0, p0_prologue(F));
    GLA_LAYER(0, 1, 0);
    PHASE(6, GEMM_F16(X16, (const f16*)(F.ws + WS_WGDNIN), GDN_LD, Hbuf, GDN_LD));
    PHASE(7, gdn_pre_phase(F));
    PHASE(8, gdn_scan_phase(F));
    PHASE(9, GEMM_F32(OGb, (const f16*)(F.ws + WS_WGDNOUT), Fb));
    if (IN(10)) { PH_BEGIN(); ln_phase(F, 1, false); SEAM(10); }
    PHASE(11, GEMM_F16(X16, (const f16*)(F.ws + WS_WS5IN), S5_LD, Hbuf, S5_LD));
    PHASE(12, s5_scan_phase(F));
    PHASE(13, GEMM_GLU());
    PHASE(14, GEMM_F32(YG, (const f16*)(F.ws + WS_WS5OUT), Fb));
    if (IN(15)) { PH_BEGIN(); ln_phase(F, 2, false); SEAM(15); }
    GLA_LAYER(1, 16, 3);
#undef IN
#undef SEAM
}

extern "C" void kernel_launch(void* const* d_in, const int* in_sizes, int n_in, void* d_out, int out_size, void* d_ws, size_t ws_size, hipStream_t stream) {
    static int grid = 0;
    if (grid == 0) {
        if (n_in != 32 || (size_t)out_size != O_END || ws_size < WS_END) { fprintf(stderr, "kernel_launch: unexpected shapes (n_in %d, out %d, ws %zu); nothing launched\n", n_in, out_size, ws_size); grid = -1; return; }
        int dev = 0, cus = 0, per_cu = 0;
        if (hipGetDevice(&dev) != hipSuccess || hipDeviceGetAttribute(&cus, hipDeviceAttributeMultiprocessorCount, dev) != hipSuccess) { grid = -1; return; }
        if (hipFuncSetAttribute((const void*)fwd_kernel, hipFuncAttributeMaxDynamicSharedMemorySize, LDS_BYTES) != hipSuccess) { fprintf(stderr, "kernel_launch: hipFuncSetAttribute failed\n"); grid = -1; return; }
        if (hipOccupancyMaxActiveBlocksPerMultiprocessor(&per_cu, (const void*)fwd_kernel, NTHR, LDS_BYTES) != hipSuccess || per_cu < 1) { fprintf(stderr, "kernel_launch: occupancy query says %d blocks per CU\n", per_cu); per_cu = 1; }
        (void)hipGetLastError();
        grid = cus;
    }
    if (grid < 0) return;
    (void)hipMemsetAsync((char*)d_ws + WS_CTL, 0, CTL_ZERO_BYTES, stream);
    Args a{};
    for (int i = 0; i < 32; ++i) a.in[i] = (const float*)d_in[i];
    a.out = (float*)d_out; a.ws = (unsigned char*)d_ws;
#if MK_PER_PHASE
    for (int p = 0; p < N_PHASES; ++p) { a.ph_lo = p; a.ph_hi = p + 1; hipLaunchKernelGGL(fwd_kernel, dim3(grid), dim3(NTHR), LDS_BYTES, stream, a); }
#else
    a.ph_lo = 0; a.ph_hi = N_PHASES;
    hipLaunchKernelGGL(fwd_kernel, dim3(grid), dim3(NTHR), LDS_BYTES, stream, a);
#endif
}
```
